# Optimizing an MI355X kernel written in HIP

```python
import jax, jax.numpy as jnp
from jax import lax
import numpy as np

D_MODEL = 1024
BATCH = 2
SEQ = 8192
DEPTH = 1

CTX_LEN = 256
GRID_W = 64
HG_HEADS = 8
HG_DK = 128
HG_DV = 128
HG_WK = HG_HEADS * HG_DK
HG_WV = HG_HEADS * HG_DV
HG_CHUNK = 32
RT_HEADS = 8
RT_DK = D_MODEL // RT_HEADS
RT_DV = 2 * D_MODEL // RT_HEADS
RT_WK = RT_HEADS * RT_DK
RT_WV = RT_HEADS * RT_DV
RT_CHUNK = 64
ROPE_BASE = 10000.0
D_FF = ((8 * D_MODEL // 3 + 255) // 256) * 256
EPS = 1e-6
GN_EPS = 1e-5
_SPLIT_SIZES = (HG_WK, HG_WK, HG_WK, HG_WV, HG_WV, RT_WK, RT_WK, RT_WV, RT_WV, D_MODEL, D_MODEL)
D_IN = sum(_SPLIT_SIZES)
_SPLIT_POINTS = tuple(int(v) for v in np.cumsum(_SPLIT_SIZES)[:-1])

kernel_name = "hybrid_hgrn2_retention_dit_block"


def _rmsnorm(x, w):
    xf = x.astype(jnp.float32)
    y = xf * lax.rsqrt(jnp.mean(xf * xf, axis=-1, keepdims=True) + EPS)
    return (y * w.astype(jnp.float32)).astype(x.dtype)


def _modulate(h, shift, scale):
    return h * (1.0 + scale) + shift


def _heads(t, n_heads):
    B, L, _ = t.shape
    return t.reshape(B, L, n_heads, -1).transpose(0, 2, 1, 3)


def _merge_heads(t):
    B, n, L, d = t.shape
    return t.transpose(0, 2, 1, 3).reshape(B, L, n * d)


def _chunk(t, C):
    B, H, L, d = t.shape
    return jnp.moveaxis(t.reshape(B, H, L // C, C, d), 2, 0)


def _unchunk(t):
    n, B, H, C, d = t.shape
    return jnp.moveaxis(t, 0, 2).reshape(B, H, n * C, d)


def _flip(t):
    return jnp.flip(t, axis=2)


def _axial_rope(L):
    rows = L // GRID_W
    row = jnp.repeat(jnp.arange(rows, dtype=jnp.float32), GRID_W)
    col = jnp.tile(jnp.arange(GRID_W, dtype=jnp.float32), rows)
    n_f = RT_DK // 4
    freqs = ROPE_BASE ** (-jnp.arange(n_f, dtype=jnp.float32) / n_f)
    ang = jnp.concatenate([row[:, None] * freqs, col[:, None] * freqs], axis=-1)
    return jnp.cos(ang), jnp.sin(ang)


def _apply_rope(t, cos, sin):
    half = t.shape[-1] // 2
    t1, t2 = t[..., :half], t[..., half:]
    return jnp.concatenate([t1 * cos - t2 * sin, t1 * sin + t2 * cos], axis=-1)


def _hgrn2_scan(q, k, v, lf, s0):
    C = HG_CHUNK
    causal = jnp.tril(jnp.ones((C, C), dtype=bool))[:, :, None]

    def step(s, blk):
        qc, kc, vc, lfc = blk
        b = jnp.cumsum(lfc, axis=2)
        rel = jnp.where(causal, b[:, :, :, None, :] - b[:, :, None, :, :], -jnp.inf)
        att = jnp.sum(qc[:, :, :, None, :] * kc[:, :, None, :, :] * jnp.exp(rel), axis=-1)
        o = (jnp.einsum('bhts,bhse->bhte', att, vc)
             + jnp.einsum('bhtd,bhde->bhte', qc * jnp.exp(b), s))
        b_last = b[:, :, -1:, :]
        s = (jnp.exp(b_last[:, :, 0, :])[..., None] * s
             + jnp.einsum('bhsd,bhse->bhde', kc * jnp.exp(b_last - b), vc))
        return s, o

    _, o = lax.scan(step, s0, (_chunk(q, C), _chunk(k, C), _chunk(v, C), _chunk(lf, C)))
    return _unchunk(o)


def _hgrn2_final_state(k, v, lf):
    b = jnp.cumsum(lf, axis=2)
    return jnp.einsum('bhsd,bhse->bhde', k * jnp.exp(b[:, :, -1:, :] - b), v)


def _retention_scan(q, k, v, log_gamma, s0):
    C = RT_CHUNK
    idx = jnp.arange(C, dtype=jnp.float32)
    diff = idx[:, None] - idx[None, :]
    lg = log_gamma[:, None, None]
    dmat = jnp.where(diff >= 0, jnp.exp(lg * jnp.maximum(diff, 0.0)), 0.0)
    q_decay = jnp.exp(log_gamma[:, None] * (idx + 1.0))[None, :, :, None]
    k_decay = jnp.exp(log_gamma[:, None] * (C - 1.0 - idx))[None, :, :, None]
    s_decay = jnp.exp(log_gamma * C)[None, :, None, None]

    def step(s, blk):
        qc, kc, vc = blk
        att = jnp.einsum('bhtd,bhsd->bhts', qc, kc) * dmat
        o = (jnp.einsum('bhts,bhse->bhte', att, vc)
             + jnp.einsum('bhtd,bhde->bhte', qc * q_decay, s))
        s = s_decay * s + jnp.einsum('bhsd,bhse->bhde', kc * k_decay, vc)
        return s, o

    _, o = lax.scan(step, s0, (_chunk(q, C), _chunk(k, C), _chunk(v, C)))
    return _unchunk(o)


def _retention_final_state(k, v, log_gamma):
    L = k.shape[2]
    w = jnp.exp(log_gamma[:, None] * (L - 1.0 - jnp.arange(L, dtype=jnp.float32)))
    return jnp.einsum('bhsd,hs,bhse->bhde', k, w, v)


def _head_rms(t):
    return t * lax.rsqrt(jnp.mean(t * t, axis=-1, keepdims=True) + EPS)


def _group_norm(t):
    mu = jnp.mean(t, axis=-1, keepdims=True)
    var = jnp.mean(jnp.square(t - mu), axis=-1, keepdims=True)
    return (t - mu) * lax.rsqrt(var + GN_EPS)


def _mixer_inputs(h, w_in, lb_f, lb_b, rope):
    p = jnp.matmul(h, w_in).astype(jnp.float32)
    hq, hf_f, hf_b, hi, hg, rq, rk, rv, rg, ga, gb = jnp.split(p, _SPLIT_POINTS, axis=-1)

    def forget(z, lb):
        k = _heads((1.0 - lb) * jax.nn.sigmoid(-z), HG_HEADS)
        lf = _heads(jnp.log(lb + (1.0 - lb) * jax.nn.sigmoid(z)), HG_HEADS)
        return k, lf

    hk_f, hlf_f = forget(hf_f, lb_f)
    hk_b, hlf_b = forget(hf_b, lb_b)
    rq = _heads(rq, RT_HEADS) * RT_DK ** -0.5
    rk = _heads(rk, RT_HEADS)
    if rope is not None:
        rq = _apply_rope(rq, rope[0], rope[1])
        rk = _apply_rope(rk, rope[0], rope[1])
    return dict(hq=_heads(hq, HG_HEADS) * HG_DK ** -0.5, hk_f=hk_f, hlf_f=hlf_f,
                hk_b=hk_b, hlf_b=hlf_b, hv=_heads(hi, HG_HEADS), hg=hg,
                rq=rq, rk=rk, rv=_heads(rv, RT_HEADS), rg=rg, ga=ga, gb=gb)


def _context_states(p, log_g_f, log_g_b):
    s_hf = _hgrn2_final_state(p["hk_f"], p["hv"], p["hlf_f"])
    s_hb = _hgrn2_final_state(_flip(p["hk_b"]), _flip(p["hv"]), _flip(p["hlf_b"]))
    s_rf = _retention_final_state(p["rk"], p["rv"], log_g_f)
    s_rb = _retention_final_state(_flip(p["rk"]), _flip(p["rv"]), log_g_b)
    return s_hf, s_hb, s_rf, s_rb


def _mix(p, s_hf, s_hb, s_rf, s_rb, log_g_f, log_g_b, hg_norm_w, w_pa, w_pb, w_out):
    hg = (_hgrn2_scan(p["hq"], p["hk_f"], p["hv"], p["hlf_f"], s_hf)
          + _flip(_hgrn2_scan(_flip(p["hq"]), _flip(p["hk_b"]), _flip(p["hv"]),
                              _flip(p["hlf_b"]), s_hb)))
    rt = (_retention_scan(p["rq"], p["rk"], p["rv"], log_g_f, s_rf)
          + _flip(_retention_scan(_flip(p["rq"]), _flip(p["rk"]), _flip(p["rv"]), log_g_b, s_rb)))
    ya = _merge_heads(_head_rms(hg)) * hg_norm_w * jax.nn.silu(p["hg"])
    yb = _merge_heads(_group_norm(rt)) * jax.nn.silu(p["rg"])
    merged = (jax.nn.sigmoid(p["ga"]) * jnp.matmul(ya, w_pa)
              + jax.nn.sigmoid(p["gb"]) * jnp.matmul(yb, w_pb))
    return jnp.matmul(merged, w_out)


def _swiglu(h, w_gate, w_up, w_down):
    return jnp.matmul(jax.nn.silu(jnp.matmul(h, w_gate)) * jnp.matmul(h, w_up), w_down)


def setup_inputs(seed: int = 0) -> dict:
    key = jax.random.key(seed)
    ks = jax.random.split(key, 24)
    f32 = jnp.float32

    def nrm(k, shape, scale):
        return jax.random.normal(k, shape, f32) * scale

    gamma = 1.0 - 2.0 ** (-5.0 - jnp.arange(RT_HEADS, dtype=f32))
    theta0 = jnp.log(gamma) - jnp.log1p(-gamma)
    return {
        "x": nrm(ks[0], (BATCH, SEQ, D_MODEL), 1.0),
        "c": nrm(ks[1], (BATCH, D_MODEL), 1.0),
        "ctx": nrm(ks[2], (BATCH, CTX_LEN, D_MODEL), 1.0),
        "c_ctx": nrm(ks[3], (D_MODEL,), 1.0),
        "w_mod": nrm(ks[4], (DEPTH, D_MODEL, 6 * D_MODEL), 0.5 * D_MODEL ** -0.5),
        "b_mod": nrm(ks[5], (DEPTH, 6 * D_MODEL), 0.02),
        "norm1_w": 1.0 + nrm(ks[6], (DEPTH, D_MODEL), 0.02),
        "norm2_w": 1.0 + nrm(ks[7], (DEPTH, D_MODEL), 0.02),
        "w_in": nrm(ks[8], (DEPTH, D_MODEL, D_IN), D_MODEL ** -0.5),
        "hg_lb_fwd": nrm(ks[9], (DEPTH + 1, HG_WK), 0.1),
        "hg_lb_bwd": nrm(ks[10], (DEPTH + 1, HG_WK), 0.1),
        "hg_norm_w": 1.0 + nrm(ks[11], (DEPTH, HG_WV), 0.02),
        "rt_theta_fwd": theta0 + nrm(ks[12], (DEPTH, RT_HEADS), 0.1),
        "rt_theta_bwd": theta0 + nrm(ks[13], (DEPTH, RT_HEADS), 0.1),
        "w_proj_hgrn": nrm(ks[14], (DEPTH, HG_WV, D_MODEL), HG_WV ** -0.5),
        "w_proj_ret": nrm(ks[15], (DEPTH, RT_WV, D_MODEL), RT_WV ** -0.5),
        "w_out": nrm(ks[16], (DEPTH, D_MODEL, D_MODEL), D_MODEL ** -0.5),
        "w_ffn_gate": nrm(ks[17], (DEPTH, D_MODEL, D_FF), D_MODEL ** -0.5),
        "w_ffn_up": nrm(ks[18], (DEPTH, D_MODEL, D_FF), D_MODEL ** -0.5),
        "w_ffn_down": nrm(ks[19], (DEPTH, D_FF, D_MODEL), D_FF ** -0.5),
        "final_norm_w": 1.0 + nrm(ks[20], (D_MODEL,), 0.02),
    }


def reference(x, c, ctx, c_ctx, w_mod, b_mod, norm1_w, norm2_w, w_in, hg_lb_fwd, hg_lb_bwd,
              hg_norm_w, rt_theta_fwd, rt_theta_bwd, w_proj_hgrn, w_proj_ret, w_out,
              w_ffn_gate, w_ffn_up, w_ffn_down, final_norm_w):
    B, L, _ = x.shape
    f32 = jnp.float32
    rope = _axial_rope(L)
    lb_f_all = jnp.cumsum(jax.nn.softmax(hg_lb_fwd.astype(f32), axis=0), axis=0)
    lb_b_all = jnp.cumsum(jax.nn.softmax(hg_lb_bwd.astype(f32), axis=0), axis=0)
    hg_zero = jnp.zeros((B, HG_HEADS, HG_DK, HG_DV), f32)
    rt_zero = jnp.zeros((B, RT_HEADS, RT_DK, RT_DV), f32)

    for l in range(DEPTH):
        last = l == DEPTH - 1
        mod_x = (jnp.matmul(jax.nn.silu(c), w_mod[l]) + b_mod[l])[:, None, :]
        mod_c = jnp.matmul(jax.nn.silu(c_ctx), w_mod[l]) + b_mod[l]
        sh1, sc1, g1, sh2, sc2, g2 = jnp.split(mod_x, 6, axis=-1)
        sh1c, sc1c, g1c, sh2c, sc2c, g2c = jnp.split(mod_c, 6, axis=-1)
        log_g_f = jax.nn.log_sigmoid(rt_theta_fwd[l].astype(f32))
        log_g_b = jax.nn.log_sigmoid(rt_theta_bwd[l].astype(f32))
        branch_w = (hg_norm_w[l], w_proj_hgrn[l], w_proj_ret[l], w_out[l])

        hc = _modulate(_rmsnorm(ctx, norm1_w[l]), sh1c, sc1c)
        pc = _mixer_inputs(hc, w_in[l], lb_f_all[l], lb_b_all[l], None)
        s_hf, s_hb, s_rf, s_rb = _context_states(pc, log_g_f, log_g_b)
        if not last:
            ctx_mix = _mix(pc, hg_zero, hg_zero, rt_zero, rt_zero, log_g_f, log_g_b, *branch_w)
            ctx = ctx + g1c * ctx_mix.astype(ctx.dtype)
            hc2 = _modulate(_rmsnorm(ctx, norm2_w[l]), sh2c, sc2c)
            ctx = ctx + g2c * _swiglu(hc2, w_ffn_gate[l], w_ffn_up[l], w_ffn_down[l])

        hx = _modulate(_rmsnorm(x, norm1_w[l]), sh1, sc1)
        px = _mixer_inputs(hx, w_in[l], lb_f_all[l], lb_b_all[l], rope)
        x_mix = _mix(px, s_hf, s_hb, s_rf, s_rb, log_g_f, log_g_b, *branch_w)
        x = x + g1 * x_mix.astype(x.dtype)
        hx2 = _modulate(_rmsnorm(x, norm2_w[l]), sh2, sc2)
        x = x + g2 * _swiglu(hx2, w_ffn_gate[l], w_ffn_up[l], w_ffn_down[l])

    return _rmsnorm(x, final_norm_w)
```

```cpp
#include <hip/hip_runtime.h>
#include <hip/hip_cooperative_groups.h>
#include <cstdio>
#include <cstdint>
namespace cg = cooperative_groups;
namespace pg8 {
#define PG8_LAS __attribute__((address_space(3)))
typedef unsigned short bf16_t;
typedef short bf16x8 __attribute__((ext_vector_type(8)));
typedef float f32x4 __attribute__((ext_vector_type(4)));
typedef unsigned u32x4 __attribute__((ext_vector_type(4)));
constexpr int BM = 256, BK = 64, HALF = 128, HTB = HALF * BK * 2  , STAGE_BYTES = 8 * HTB, NXCD = 8, WGM = 8;

__host__ __device__ __forceinline__ int lds_byte(int r, int c) { const int st = (r >> 4) * 2 + (c >> 5), rr = r & 15, cc = c & 31, ob = rr * 64 + cc * 2; return st * 1024 + (ob ^ (((ob >> 9) & 1) << 5)); }
__host__ __device__ __forceinline__ void stage_rc(int b, int& R, int& C) { const int st = b / 1024, sb = b % 1024, swz = sb ^ (((sb >> 9) & 1) << 5); R = (st >> 1) * 16 + swz / 64; C = (st & 1) * 32 + (swz % 64) / 2; }
__host__ __device__ __forceinline__ int perm32(int rho) { const int n = rho >> 4, i = rho & 15; return 8 * (i >> 2) + 4 * n + (i & 3); }

struct Unit { int pm, pn; };
struct Gemm { const bf16_t* A; const bf16_t* Bt; int M, N, K; };

struct StaticOrder {
    int nM, nN, nwg, G, c;
    __host__ __device__ void init(int M, int N, int G_, int c_) { nM = M / BM; nN = N / BM; nwg = nM * nN; G = G_; c = c_; }
    __host__ __device__ bool next(int i, Unit& u) const {
        const long L = (long)i * G + c; if (L >= nwg) return false;
        int wgid = (int)L; { const int q = nwg / NXCD, r = nwg % NXCD, xcd = wgid % NXCD, off = wgid / NXCD; wgid = (xcd < r ? xcd * (q + 1) : r * (q + 1) + (xcd - r) * q) + off; }
        const int nig = WGM * nN, gid = wgid / nig, fm = gid * WGM, gsz = (nM - fm) < WGM ? (nM - fm) : WGM;
        u.pm = fm + ((wgid % nig) % gsz); u.pn = (wgid % nig) / gsz; return true;
    }
    __device__ __forceinline__ void a_ready(const Unit&) const {}
    __device__ __forceinline__ void done(const Unit&) const {}
};

__device__ __forceinline__ unsigned cvt_pk_bf16(float lo, float hi) { unsigned r; asm volatile("v_cvt_pk_bf16_f32 %0, %1, %2" : "=v"(r) : "v"(lo), "v"(hi)); return r; }
typedef float f32x2 __attribute__((ext_vector_type(2)));
template <class Epi, class Sched, bool ALIGN_EPI = false, bool SP2 = false>
__device__ __forceinline__ void gemm_phase(PG8_LAS unsigned char* lds, const Gemm g, const Sched& S, const Epi& E) {
    int tid_l = threadIdx.x; asm volatile("" : "+v"(tid_l));
    const int tid = tid_l, wid = __builtin_amdgcn_readfirstlane(tid >> 6), lane = tid & 63, wr = wid >> 2, wc = wid & 3, fr = lane & 15, fq = lane >> 4;
    const int K = g.K, nt = K / BK;
    unsigned voffA[2], voffB[2];
#pragma unroll
    for (int i = 0; i < 2; ++i) { int R, C; stage_rc(tid * 16 + i * 8192, R, C); const int Rb = Epi::PERM ? ((R & ~31) + perm32(R & 31)) : R;
        voffA[i] = (unsigned)(R * K + C) * 2u; voffB[i] = (unsigned)(Rb * K + C) * 2u; }
    const size_t kstep = (size_t)(BK * 2);
    const size_t hstep = (size_t)HALF * K * 2;
    const size_t tstep = 2 * hstep;
    const unsigned ldsw = (unsigned)wid * 1024u;
    const int aoff = lds_byte(wr * 64 + fr, fq * 8), boff = lds_byte(wc * 32 + fr, fq * 8);
#define PG8_SA(b, h) (((b) * 2 + (h)) * HTB)
#define PG8_SB(b, h) ((4 + (b) * 2 + (h)) * HTB)
#define PG8_STAGE(bufoff, gbase, voff) do { _Pragma("unroll") for (int _i = 0; _i < 2; ++_i) \
        __builtin_amdgcn_global_load_lds((const unsigned*)((const char*)(gbase) + (voff)[_i]), (PG8_LAS unsigned*)(lds + (bufoff) + ldsw + _i * 8192), 16, 0, 0); } while (0)
#define PG8_LDA(dst, b, h) do { _Pragma("unroll") for (int m = 0; m < 4; ++m) _Pragma("unroll") for (int k = 0; k < 2; ++k) dst[m][k] = *(const PG8_LAS bf16x8*)(lds + PG8_SA(b, h) + aoff + m * 2048 + k * 1024); } while (0)
#define PG8_LDB(dst, b, h) do { _Pragma("unroll") for (int n = 0; n < 2; ++n) _Pragma("unroll") for (int k = 0; k < 2; ++k) dst[n][k] = *(const PG8_LAS bf16x8*)(lds + PG8_SB(b, h) + boff + n * 2048 + k * 1024); } while (0)
#define PG8_MMA(ai, bj, At, Bt) do { __builtin_amdgcn_s_setprio(1); _Pragma("unroll") for (int m = 0; m < 4; ++m) _Pragma("unroll") for (int n = 0; n < 2; ++n) _Pragma("unroll") for (int k = 0; k < 2; ++k) \
        acc[ai][bj][m][n] = __builtin_amdgcn_mfma_f32_16x16x32_bf16(Bt[n][k], At[m][k], acc[ai][bj][m][n], 0, 0, 0); __builtin_amdgcn_s_setprio(0); } while (0)
#define PG8_WAIT_V(n) asm volatile("s_waitcnt vmcnt(" #n ")" ::: "memory")
#define PG8_WAIT_L(n) asm volatile("s_waitcnt lgkmcnt(" #n ")" ::: "memory")
#define PG8_BAR __builtin_amdgcn_s_barrier()
#define PG8_SCHED __builtin_amdgcn_sched_barrier(0)
    Unit cur, nxt; int ui = 0;
    if (!S.next(0, cur)) return;
    f32x4 acc[2][2][4][2];
#pragma unroll
    for (int a = 0; a < 2; ++a)
#pragma unroll
        for (int b = 0; b < 2; ++b)
#pragma unroll
            for (int m = 0; m < 4; ++m)
#pragma unroll
                for (int n = 0; n < 2; ++n) acc[a][b][m][n] = (f32x4){0.f, 0.f, 0.f, 0.f};
    bf16x8 At[4][2], B0[2][2], B1[2][2];
    const char* cA = (const char*)g.A + (size_t)cur.pm * tstep; const char* cB = (const char*)g.Bt + (size_t)cur.pn * tstep;
    S.a_ready(cur);
    if constexpr (SP2) {
        PG8_STAGE(PG8_SB(0, 0), cB, voffB); PG8_STAGE(PG8_SB(0, 1), cB + hstep, voffB); PG8_STAGE(PG8_SA(0, 0), cA, voffA); PG8_STAGE(PG8_SA(0, 1), cA + hstep, voffA);
        if (wr == 1) PG8_BAR;
        PG8_WAIT_V(2); PG8_BAR;
        PG8_STAGE(PG8_SB(1, 0), cB + kstep, voffB); PG8_STAGE(PG8_SA(1, 0), cA + kstep, voffA); PG8_STAGE(PG8_SB(1, 1), cB + hstep + kstep, voffB);
        PG8_WAIT_V(6); PG8_BAR;
    } else {
        PG8_STAGE(PG8_SB(0, 0), cB, voffB); PG8_STAGE(PG8_SA(0, 0), cA, voffA); PG8_STAGE(PG8_SB(0, 1), cB + hstep, voffB); PG8_STAGE(PG8_SA(0, 1), cA + hstep, voffA);
        if (wr == 1) PG8_BAR;
        PG8_WAIT_V(4); PG8_BAR;
        PG8_STAGE(PG8_SB(1, 0), cB + kstep, voffB); PG8_STAGE(PG8_SA(1, 0), cA + kstep, voffA); PG8_STAGE(PG8_SB(1, 1), cB + hstep + kstep, voffB);
        PG8_WAIT_V(6); PG8_BAR;
    }
    for (;;) {
        const bool has_next = S.next(ui + 1, nxt);
        const char* nA = has_next ? (const char*)g.A + (size_t)nxt.pm * tstep : cA; const char* nB = has_next ? (const char*)g.Bt + (size_t)nxt.pn * tstep : cB;
        for (int t = 0; t < nt; t += 2) {
            const bool last = (t == nt - 2);
            const char* a1 = cA + (size_t)(t + 1) * kstep;
            const char* a2 = last ? nA : cA + (size_t)(t + 2) * kstep; const char* b2 = last ? nB : cB + (size_t)(t + 2) * kstep;
            const char* a3 = a2 + kstep; const char* b3 = b2 + kstep;
            if (last && has_next) S.a_ready(nxt);
            if constexpr (SP2) {
            PG8_LDB(B0, 0, 0); PG8_LDB(B1, 0, 1); PG8_SCHED; PG8_LDA(At, 0, 0); PG8_STAGE(PG8_SA(1, 1), a1 + hstep, voffA);
            PG8_WAIT_V(8); PG8_WAIT_L(0); PG8_BAR; PG8_MMA(0, 0, At, B0); PG8_MMA(0, 1, At, B1); PG8_BAR; PG8_SCHED;
            PG8_LDA(At, 0, 1); PG8_STAGE(PG8_SB(0, 0), b2, voffB); PG8_STAGE(PG8_SB(0, 1), b2 + hstep, voffB); PG8_STAGE(PG8_SA(0, 0), a2, voffA);
            PG8_WAIT_V(8); PG8_WAIT_L(0); PG8_BAR; PG8_MMA(1, 0, At, B0); PG8_MMA(1, 1, At, B1); PG8_BAR; PG8_SCHED;
            PG8_LDB(B0, 1, 0); PG8_LDB(B1, 1, 1); PG8_SCHED; PG8_LDA(At, 1, 0); PG8_STAGE(PG8_SA(0, 1), a2 + hstep, voffA);
            PG8_WAIT_V(8); PG8_WAIT_L(0); PG8_BAR; PG8_MMA(0, 0, At, B0); PG8_MMA(0, 1, At, B1); PG8_BAR; PG8_SCHED;
            PG8_LDA(At, 1, 1); PG8_STAGE(PG8_SB(1, 0), b3, voffB); PG8_STAGE(PG8_SB(1, 1), b3 + hstep, voffB); PG8_STAGE(PG8_SA(1, 0), a3, voffA);
            PG8_WAIT_V(8); PG8_WAIT_L(0); PG8_BAR; PG8_MMA(1, 0, At, B0); PG8_MMA(1, 1, At, B1); PG8_BAR; PG8_SCHED;
            } else {
            PG8_LDB(B0, 0, 0); PG8_SCHED; PG8_LDA(At, 0, 0); PG8_STAGE(PG8_SA(1, 1), a1 + hstep, voffA);
            PG8_WAIT_L(8); PG8_BAR; PG8_WAIT_L(0); PG8_MMA(0, 0, At, B0); PG8_BAR; PG8_SCHED;
            PG8_LDB(B1, 0, 1); PG8_STAGE(PG8_SB(0, 0), b2, voffB);
            PG8_BAR; PG8_WAIT_L(0); PG8_MMA(0, 1, At, B1); PG8_BAR;
            PG8_LDA(At, 0, 1); PG8_STAGE(PG8_SA(0, 0), a2, voffA);
            PG8_BAR; PG8_WAIT_L(0); PG8_MMA(1, 0, At, B0); PG8_BAR; PG8_SCHED;
            PG8_STAGE(PG8_SB(0, 1), b2 + hstep, voffB);
            PG8_WAIT_V(6); PG8_BAR; PG8_MMA(1, 1, At, B1); PG8_BAR;
            PG8_LDB(B0, 1, 0); PG8_SCHED; PG8_LDA(At, 1, 0); PG8_STAGE(PG8_SA(0, 1), a2 + hstep, voffA);
            PG8_WAIT_L(8); PG8_BAR; PG8_WAIT_L(0); PG8_MMA(0, 0, At, B0); PG8_BAR; PG8_SCHED;
            PG8_LDB(B1, 1, 1); PG8_STAGE(PG8_SB(1, 0), b3, voffB);
            PG8_BAR; PG8_WAIT_L(0); PG8_MMA(0, 1, At, B1); PG8_BAR;
            PG8_LDA(At, 1, 1); PG8_STAGE(PG8_SA(1, 0), a3, voffA);
            PG8_BAR; PG8_WAIT_L(0); PG8_MMA(1, 0, At, B0); PG8_BAR; PG8_SCHED;
            PG8_STAGE(PG8_SB(1, 1), b3 + hstep, voffB);
            PG8_WAIT_V(6); PG8_BAR; PG8_MMA(1, 1, At, B1); PG8_BAR;
            }
        }
        if constexpr (ALIGN_EPI) { if (wr == 0) PG8_BAR; }
        if constexpr (!Epi::AFTER_DRAIN) { E(acc, cur, wr, wc, fr, fq); S.done(cur); }
        if (!has_next) break;
#pragma unroll
        for (int a = 0; a < 2; ++a)
#pragma unroll
            for (int b = 0; b < 2; ++b)
#pragma unroll
                for (int m = 0; m < 4; ++m)
#pragma unroll
                    for (int n = 0; n < 2; ++n) acc[a][b][m][n] = (f32x4){0.f, 0.f, 0.f, 0.f};
        cur = nxt; cA = nA; cB = nB; ++ui;
        if constexpr (ALIGN_EPI) { if (wr == 1) PG8_BAR; }
    }
    PG8_WAIT_V(0);
    if constexpr (!ALIGN_EPI) { if (wr == 0) PG8_BAR; }
    PG8_BAR;
    if constexpr (Epi::AFTER_DRAIN) { E.fused(acc, cur, wr, wc, fr, fq, lds, wid, lane); S.done(cur); }
#undef PG8_SA
#undef PG8_SB
#undef PG8_STAGE
#undef PG8_LDA
#undef PG8_LDB
#undef PG8_MMA
#undef PG8_WAIT_V
#undef PG8_WAIT_L
#undef PG8_BAR
#undef PG8_SCHED
}
}

#define LAS __attribute__((address_space(3)))
typedef unsigned short bf16_t;
typedef short bf16x8 __attribute__((ext_vector_type(8)));
typedef short s16x4 __attribute__((ext_vector_type(4)));
typedef float f32x4 __attribute__((ext_vector_type(4)));
typedef float f32x2 __attribute__((ext_vector_type(2)));
typedef float f32x16 __attribute__((ext_vector_type(16)));
typedef unsigned u32x4 __attribute__((ext_vector_type(4)));
typedef unsigned u32x2 __attribute__((ext_vector_type(2)));
typedef __bf16 bf16x2_t __attribute__((ext_vector_type(2)));
typedef _Float16 f16x2_t __attribute__((ext_vector_type(2)));

constexpr int DM = 1024, NBATCH = 2, SEQ = 8192, CTXL = 256;
constexpr int MX = NBATCH * SEQ;
constexpr int MC = NBATCH * CTXL;
constexpr int MT = MX + MC;
constexpr int DFF = 2816;
constexpr int NTHREADS = 512, NWAVES = 8;
constexpr int LDS_BYTES = 131072 + 1024;

constexpr size_t SLOT_ELEMS = (size_t)MT * 1024;
constexpr size_t WS_W_IN  = 0;
constexpr size_t WS_W_PA  = WS_W_IN  + (size_t)13312 * 1024 * 2;
constexpr size_t WS_W_PB  = WS_W_PA  + (size_t)1024 * 1024 * 2;
constexpr size_t WS_W_OUT = WS_W_PB  + (size_t)1024 * 2048 * 2;
constexpr size_t WS_W_GU  = WS_W_OUT + (size_t)1024 * 1024 * 2;
constexpr size_t WS_W_DN  = WS_W_GU  + (size_t)5632 * 1024 * 2;
constexpr size_t WS_HX    = WS_W_DN  + (size_t)1024 * 2816 * 2;
constexpr size_t WS_YA    = WS_HX    + SLOT_ELEMS * 2;
constexpr size_t WS_SCR   = WS_YA    + (size_t)MX * 1024 * 2;
constexpr size_t WS_MODP  = WS_SCR   + 4 * SLOT_ELEMS * 2;
constexpr size_t WS_MODF  = WS_MODP  + (size_t)8 * 3 * 6144 * 4;
constexpr size_t WS_LBV   = WS_MODF  + (size_t)3 * 6144 * 4;
constexpr size_t WS_ROPE  = WS_LBV   + (size_t)2 * 1024 * 4;
constexpr size_t WS_CSH   = WS_ROPE  + (size_t)(4096 + 4096 + 2048 + 2048) * 4;
constexpr size_t WS_CSR   = WS_CSH   + (size_t)2 * 2 * 8 * 128 * 128 * 4;
constexpr size_t WS_END   = WS_CSR   + (size_t)2 * 2 * 8 * 128 * 256 * 4;

struct Params { const float* in[21]; float* out; unsigned char* ws; };

__device__ __forceinline__ unsigned pkbf(float lo, float hi) { f32x2 v = {lo, hi}; bf16x2_t b = __builtin_convertvector(v, bf16x2_t); return __builtin_bit_cast(unsigned, b); }
__device__ __forceinline__ unsigned pkf16(float lo, float hi) { f32x2 v = {lo, hi}; f16x2_t b = __builtin_convertvector(v, f16x2_t); return __builtin_bit_cast(unsigned, b); }
__device__ __forceinline__ float bf2f(unsigned short u) { return __builtin_bit_cast(float, (unsigned)u << 16); }
__device__ __forceinline__ float bflo(unsigned u) { return __builtin_bit_cast(float, u << 16); }
__device__ __forceinline__ float bfhi(unsigned u) { return __builtin_bit_cast(float, u & 0xffff0000u); }
__device__ __forceinline__ float f16tof(unsigned short u) { return (float)__builtin_bit_cast(_Float16, u); }
__device__ __forceinline__ float sigmoidf_(float z) { return __builtin_amdgcn_rcpf(1.0f + __expf(-z)); }
__device__ __forceinline__ float siluf_(float z) { return z * sigmoidf_(z); }
__device__ __forceinline__ float wave_sum(float v) {
#pragma unroll
    for (int o = 1; o < 64; o <<= 1) v += __shfl_xor(v, o);
    return v;
}
#define LDS_WAIT() asm volatile("s_waitcnt lgkmcnt(0)" ::: "memory")

template <int mode> struct EpiAll {
    static constexpr bool PERM = true, AFTER_DRAIN = false;
    unsigned char* ws; const float* x; float* out;
    __device__ __forceinline__ void store8(bf16_t* p, const f32x4& a, const f32x4& b) const {
        u32x4 w; w.x = pkbf(a[0], a[1]); w.y = pkbf(a[2], a[3]); w.z = pkbf(b[0], b[1]); w.w = pkbf(b[2], b[3]); *(u32x4*)p = w;
    }
    __device__ __forceinline__ void operator()(const f32x4 (&acc)[2][2][4][2], const pg8::Unit& u, int wr, int wc, int fr, int fq) const {
        const int row0 = u.pm * 256 + wr * 64 + fr;
        const int cin = wc * 32 + 8 * fq;
        bf16_t* SCR = (bf16_t*)(ws + WS_SCR);
        if (mode == 1) {
            const int seg = u.pn >> 2, col0 = (u.pn & 3) * 256 + cin;
            bf16_t* base = SCR + (size_t)seg * SLOT_ELEMS;
            if (seg == 1 || seg == 2) {
                const float* lbv = (const float*)(ws + WS_LBV) + (seg - 1) * 1024;
#pragma unroll
                for (int bj = 0; bj < 2; ++bj) {
                    const f32x4 l0 = *(const f32x4*)(lbv + col0 + bj * 128), l1 = *(const f32x4*)(lbv + col0 + bj * 128 + 4);
#pragma unroll
                    for (int ai = 0; ai < 2; ++ai)
#pragma unroll
                        for (int m = 0; m < 4; ++m) {
                            float v[8];
#pragma unroll
                            for (int j = 0; j < 4; ++j) {
                                const float z0 = acc[ai][bj][m][0][j], z1 = acc[ai][bj][m][1][j];
                                v[j] = __logf(l0[j] + (1.0f - l0[j]) * sigmoidf_(z0));
                                v[4 + j] = __logf(l1[j] + (1.0f - l1[j]) * sigmoidf_(z1));
                            }
                            u32x4 w; w.x = pkf16(v[0], v[1]); w.y = pkf16(v[2], v[3]); w.z = pkf16(v[4], v[5]); w.w = pkf16(v[6], v[7]);
                            *(u32x4*)(base + (size_t)(row0 + ai * 128 + m * 16) * 1024 + col0 + bj * 128) = w;
                        }
                }
            } else {
                const float sc = seg == 0 ? 0.08838834764831845f : 1.0f;
#pragma unroll
                for (int ai = 0; ai < 2; ++ai)
#pragma unroll
                    for (int m = 0; m < 4; ++m)
#pragma unroll
                        for (int bj = 0; bj < 2; ++bj)
                            store8(base + (size_t)(row0 + ai * 128 + m * 16) * 1024 + col0 + bj * 128, acc[ai][bj][m][0] * sc, acc[ai][bj][m][1] * sc);
            }
        } else if (mode == 2) {
            if (u.pn < 8) {
                const int seg = u.pn >> 2, tile = u.pn & 3;
                bf16_t* base = SCR + (size_t)seg * SLOT_ELEMS;
                const float sc = seg == 0 ? 0.08838834764831845f : 1.0f;
                const int head = 2 * tile + (cin >> 6), e = cin & 63;
                const float* rp = (const float*)(ws + WS_ROPE);
                const bool latent = u.pm < 64;
#pragma unroll
                for (int ai = 0; ai < 2; ++ai)
#pragma unroll
                    for (int m = 0; m < 4; ++m) {
                        const int row = row0 + ai * 128 + m * 16;
                        f32x4 c0 = {1.f, 1.f, 1.f, 1.f}, c1 = c0, s0 = {0.f, 0.f, 0.f, 0.f}, s1 = s0;
                        if (latent) {
                            const int pos = row & (SEQ - 1), prow = pos >> 6, pcol = pos & 63;
                            const float* cp = e < 32 ? rp + prow * 32 + e : rp + 8192 + pcol * 32 + (e - 32);
                            const float* sp = e < 32 ? rp + 4096 + prow * 32 + e : rp + 8192 + 2048 + pcol * 32 + (e - 32);
                            c0 = *(const f32x4*)cp; c1 = *(const f32x4*)(cp + 4); s0 = *(const f32x4*)sp; s1 = *(const f32x4*)(sp + 4);
                        }
                        const f32x4 a0 = acc[ai][0][m][0] * sc, a1 = acc[ai][0][m][1] * sc, b0 = acc[ai][1][m][0] * sc, b1 = acc[ai][1][m][1] * sc;
                        bf16_t* p = base + (size_t)row * 1024 + head * 128 + e;
                        store8(p, a0 * c0 - b0 * s0, a1 * c1 - b1 * s1);
                        store8(p + 64, a0 * s0 + b0 * c0, a1 * s1 + b1 * c1);
                        asm volatile("" ::: "memory");
                    }
            } else {
                bf16_t* base = SCR + 2 * SLOT_ELEMS;
                const int col0 = (u.pn - 8) * 256 + cin;
#pragma unroll
                for (int ai = 0; ai < 2; ++ai)
#pragma unroll
                    for (int m = 0; m < 4; ++m)
#pragma unroll
                        for (int bj = 0; bj < 2; ++bj)
                            store8(base + (size_t)(row0 + ai * 128 + m * 16) * 2048 + col0 + bj * 128, acc[ai][bj][m][0], acc[ai][bj][m][1]);
            }
        } else if (mode == 3) {
            bf16_t* p; int ld, col0; bool gate;
            if (u.pn < 4) { p = (bf16_t*)(ws + WS_YA); ld = 1024; col0 = u.pn * 256 + cin; gate = true; }
            else if (u.pn < 12) { p = SCR; ld = 2048; col0 = (u.pn - 4) * 256 + cin; gate = true; }
            else { const int s = (u.pn - 12) >> 2; p = SCR + (size_t)(2 + s) * SLOT_ELEMS; ld = 1024; col0 = ((u.pn - 12) & 3) * 256 + cin; gate = false; }
#pragma unroll
            for (int ai = 0; ai < 2; ++ai)
#pragma unroll
                for (int m = 0; m < 4; ++m)
#pragma unroll
                    for (int bj = 0; bj < 2; ++bj) {
                        bf16_t* q = p + (size_t)(row0 + ai * 128 + m * 16) * ld + col0 + bj * 128;
                        f32x4 v0 = acc[ai][bj][m][0], v1 = acc[ai][bj][m][1];
                        if (gate) {
                            const u32x4 y = *(const u32x4*)q;
                            v0[0] = siluf_(v0[0]) * bflo(y.x); v0[1] = siluf_(v0[1]) * bfhi(y.x); v0[2] = siluf_(v0[2]) * bflo(y.y); v0[3] = siluf_(v0[3]) * bfhi(y.y);
                            v1[0] = siluf_(v1[0]) * bflo(y.z); v1[1] = siluf_(v1[1]) * bfhi(y.z); v1[2] = siluf_(v1[2]) * bflo(y.w); v1[3] = siluf_(v1[3]) * bfhi(y.w);
                        } else {
#pragma unroll
                            for (int j = 0; j < 4; ++j) { v0[j] = sigmoidf_(v0[j]); v1[j] = sigmoidf_(v1[j]); }
                        }
                        store8(q, v0, v1);
                        asm volatile("" ::: "memory");
                    }
        } else if (mode == 4 || mode == 5) {
            const bf16_t* sg = SCR + (size_t)(mode == 4 ? 2 : 3) * SLOT_ELEMS;
            bf16_t* mg = (bf16_t*)(ws + WS_HX);
            const int col0 = u.pn * 256 + cin;
#pragma unroll
            for (int ai = 0; ai < 2; ++ai)
#pragma unroll
                for (int m = 0; m < 4; ++m)
#pragma unroll
                    for (int bj = 0; bj < 2; ++bj) {
                        const size_t off = (size_t)(row0 + ai * 128 + m * 16) * 1024 + col0 + bj * 128;
                        const u32x4 g = *(const u32x4*)(sg + off);
                        f32x4 v0 = acc[ai][bj][m][0], v1 = acc[ai][bj][m][1];
                        v0[0] *= bflo(g.x); v0[1] *= bfhi(g.x); v0[2] *= bflo(g.y); v0[3] *= bfhi(g.y);
                        v1[0] *= bflo(g.z); v1[1] *= bfhi(g.z); v1[2] *= bflo(g.w); v1[3] *= bfhi(g.w);
                        if (mode == 4) { *(f32x4*)(out + off) = v0; *(f32x4*)(out + off + 4) = v1; }
                        else { v0 += *(const f32x4*)(out + off); v1 += *(const f32x4*)(out + off + 4); store8(mg + off, v0, v1); }
                        asm volatile("" ::: "memory");
                    }
        } else if (mode == 6 || mode == 8) {
            const int col0 = u.pn * 256 + cin;
            const float* res = mode == 6 ? x : out;
            const float* gv = (const float*)(ws + WS_MODF) + (size_t)(u.pm >= 32 ? 1 : 0) * 6144 + (mode == 6 ? 2048 : 5120);
#pragma unroll
            for (int bj = 0; bj < 2; ++bj) {
                const f32x4 g0 = *(const f32x4*)(gv + col0 + bj * 128), g1 = *(const f32x4*)(gv + col0 + bj * 128 + 4);
#pragma unroll
                for (int ai = 0; ai < 2; ++ai)
#pragma unroll
                    for (int m = 0; m < 4; ++m) {
                        const size_t off = (size_t)(row0 + ai * 128 + m * 16) * 1024 + col0 + bj * 128;
                        const f32x4 r0 = *(const f32x4*)(res + off), r1 = *(const f32x4*)(res + off + 4);
                        *(f32x4*)(out + off) = r0 + g0 * acc[ai][bj][m][0];
                        *(f32x4*)(out + off + 4) = r1 + g1 * acc[ai][bj][m][1];
                        asm volatile("" ::: "memory");
                    }
            }
        } else {
            const int col0 = u.pn * 128 + cin;
#pragma unroll
            for (int ai = 0; ai < 2; ++ai)
#pragma unroll
                for (int m = 0; m < 4; ++m) {
                    f32x4 v0, v1;
#pragma unroll
                    for (int j = 0; j < 4; ++j) { v0[j] = siluf_(acc[ai][0][m][0][j]) * acc[ai][1][m][0][j]; v1[j] = siluf_(acc[ai][0][m][1][j]) * acc[ai][1][m][1][j]; }
                    store8(SCR + (size_t)(row0 + ai * 128 + m * 16) * DFF + col0, v0, v1);
                }
        }
    }
};

__device__ __forceinline__ void p0_transpose_item(const float* W, int K, int N, bf16_t* WT, int drow0, int k0, int n0, LAS float* scr, int lane) {
#pragma unroll 8
    for (int i = 0; i < 32; ++i) { const int kk = 2 * i + (lane >> 5); scr[kk * 33 + (lane & 31)] = W[(size_t)(k0 + kk) * N + n0 + (lane & 31)]; }
    LDS_WAIT(); asm volatile("" ::: "memory");
    const int c = lane & 7;
#pragma unroll
    for (int j = 0; j < 4; ++j) { const int n = (lane >> 3) + 8 * j; const LAS float* s = scr + (8 * c) * 33 + n;
        u32x4 o; o.x = pkbf(s[0 * 33], s[1 * 33]); o.y = pkbf(s[2 * 33], s[3 * 33]); o.z = pkbf(s[4 * 33], s[5 * 33]); o.w = pkbf(s[6 * 33], s[7 * 33]);
        *(u32x4*)(WT + (size_t)(drow0 + n) * K + k0 + 8 * c) = o; }
    LDS_WAIT(); asm volatile("" ::: "memory");
}
__device__ __forceinline__ int win_map(int c) {
    if (c < 4096) return c;
    if (c < 5120) return 8192 + (c - 4096);
    if (c < 7168) { const int seg = (c - 5120) >> 10, cc = (c - 5120) & 1023, head = cc >> 7, half = (cc >> 6) & 1, e = cc & 63;
        return 4096 + seg * 1024 + 256 * (head >> 1) + 128 * half + 64 * (head & 1) + e; }
    if (c < 9216) return c - 1024;
    return c;
}
__device__ __forceinline__ void p0_phase(const Params& P, LAS unsigned char* lds) {
    int tid_l = threadIdx.x; asm volatile("" : "+v"(tid_l)); const int tid = tid_l, lane = tid & 63, wave = tid >> 6, G = gridDim.x;
    unsigned char* ws = P.ws;
    LAS float* scr = (LAS float*)(lds + wave * 16384);
    const int gw = blockIdx.x * NWAVES + wave, NGW = G * NWAVES;
    constexpr int I0 = 16 * 416, I1 = 16 * 32, I2 = 32 * 32, I3 = 16 * 32, I4 = 16 * 88, I5 = 16 * 88, I6 = 44 * 32;
    constexpr int NITEMS = I0 + I1 + I2 + I3 + I4 + I5 + I6;
    for (int it = gw; it < NITEMS; it += NGW) {
        int r = it;
        if (r < I0) { const int kb = r / 416, nb = r % 416; p0_transpose_item(P.in[8], 1024, 13312, (bf16_t*)(ws + WS_W_IN), win_map(nb * 32), kb * 64, nb * 32, scr, lane); continue; } r -= I0;
        if (r < I1) { const int kb = r / 32, nb = r % 32; p0_transpose_item(P.in[14], 1024, 1024, (bf16_t*)(ws + WS_W_PA), nb * 32, kb * 64, nb * 32, scr, lane); continue; } r -= I1;
        if (r < I2) { const int kb = r / 32, nb = r % 32; p0_transpose_item(P.in[15], 2048, 1024, (bf16_t*)(ws + WS_W_PB), nb * 32, kb * 64, nb * 32, scr, lane); continue; } r -= I2;
        if (r < I3) { const int kb = r / 32, nb = r % 32; p0_transpose_item(P.in[16], 1024, 1024, (bf16_t*)(ws + WS_W_OUT), nb * 32, kb * 64, nb * 32, scr, lane); continue; } r -= I3;
        if (r < I4) { const int kb = r / 88, nb = r % 88, c = nb * 32; p0_transpose_item(P.in[17], 1024, DFF, (bf16_t*)(ws + WS_W_GU), 256 * (c >> 7) + (c & 127), kb * 64, c, scr, lane); continue; } r -= I4;
        if (r < I5) { const int kb = r / 88, nb = r % 88, c = nb * 32; p0_transpose_item(P.in[18], 1024, DFF, (bf16_t*)(ws + WS_W_GU), 256 * (c >> 7) + 128 + (c & 127), kb * 64, c, scr, lane); continue; } r -= I5;
        { const int kb = r / 32, nb = r % 32; p0_transpose_item(P.in[19], DFF, 1024, (bf16_t*)(ws + WS_W_DN), nb * 32, kb * 64, nb * 32, scr, lane); }
    }
    __syncthreads();
    LAS float* sv = (LAS float*)lds;
    float* modp = (float*)(ws + WS_MODP);
    for (int item = blockIdx.x; item < 96; item += G) {
        const int ks = item / 12, cb = item % 12, col = cb * 512 + tid;
        if (tid < 384) { const int r = tid >> 7, kk = tid & 127; const float cv = r < 2 ? P.in[1][r * 1024 + ks * 128 + kk] : P.in[3][ks * 128 + kk]; sv[tid] = cv / (1.0f + expf(-cv)); }
        __syncthreads();
        float a0 = 0.f, a1 = 0.f, a2 = 0.f;
        const float* wp = P.in[4] + (size_t)(ks * 128) * 6144 + col;
#pragma unroll 8
        for (int kk = 0; kk < 128; ++kk) { const float w = wp[(size_t)kk * 6144]; a0 += sv[kk] * w; a1 += sv[128 + kk] * w; a2 += sv[256 + kk] * w; }
        modp[(size_t)(ks * 3 + 0) * 6144 + col] = a0; modp[(size_t)(ks * 3 + 1) * 6144 + col] = a1; modp[(size_t)(ks * 3 + 2) * 6144 + col] = a2;
        __syncthreads();
    }
    const int gt = blockIdx.x * NTHREADS + tid, NGT = G * NTHREADS;
    float* lbv = (float*)(ws + WS_LBV); float* rp = (float*)(ws + WS_ROPE);
    for (int i = gt; i < 2048; i += NGT) { const float* s = i < 1024 ? P.in[9] : P.in[10]; const int k = i & 1023; const float a0 = s[k], a1 = s[1024 + k]; lbv[i] = 1.0f / (1.0f + expf(a1 - a0)); }
    for (int i = gt; i < 4096 + 2048; i += NGT) {
        const bool isrow = i < 4096; const int ii = isrow ? i : i - 4096; const int p = ii >> 5, f = ii & 31;
        const float fr = powf(10000.0f, -(float)f / 32.0f); const float ang = (float)p * fr; float sn, cs; sincosf(ang, &sn, &cs);
        if (isrow) { rp[ii] = cs; rp[4096 + ii] = sn; } else { rp[8192 + ii] = cs; rp[8192 + 2048 + ii] = sn; }
    }
}

__device__ __forceinline__ void norm_mod_phase(const float* src0, const float* src1, int nrows, bf16_t* dst, const float* w,
                                               const float* modsrc, int nparts, const float* bias, int sh_off, int sc_off, LAS unsigned char* lds) {
    int tid_l = threadIdx.x; asm volatile("" : "+v"(tid_l)); const int tid = tid_l, lane = tid & 63, wave = tid >> 6, G = gridDim.x;
    LAS float* CA = (LAS float*)lds;
    LAS float* CB = CA + 3072;
    for (int idx = tid; idx < 3072; idx += NTHREADS) {
        const int r = idx >> 10, k = idx & 1023;
        float sh = bias ? bias[sh_off + k] : 0.f, sc = bias ? bias[sc_off + k] : 0.f;
        for (int p = 0; p < nparts; ++p) { sh += modsrc[(size_t)(p * 3 + r) * 6144 + sh_off + k]; sc += modsrc[(size_t)(p * 3 + r) * 6144 + sc_off + k]; }
        CA[idx] = w[k] * (1.0f + sc); CB[idx] = sh;
    }
    __syncthreads();
    for (int row = blockIdx.x * NWAVES + wave; row < nrows; row += G * NWAVES) {
        const float* xr = row < MX ? src0 + (size_t)row * 1024 : src1 + (size_t)(row - MX) * 1024;
        const int r = row < MX ? (row >= SEQ ? 1 : 0) : 2;
        f32x4 v[4]; float s = 0.f;
#pragma unroll
        for (int j = 0; j < 4; ++j) { v[j] = *(const f32x4*)(xr + 4 * lane + 256 * j); s += (v[j][0] * v[j][0] + v[j][1] * v[j][1]) + (v[j][2] * v[j][2] + v[j][3] * v[j][3]); }
        const float rstd = rsqrtf(wave_sum(s) * (1.0f / 1024.0f) + 1e-6f);
#pragma unroll
        for (int j = 0; j < 4; ++j) {
            const f32x4 a = *(const LAS f32x4*)(CA + r * 1024 + 4 * lane + 256 * j), b = *(const LAS f32x4*)(CB + r * 1024 + 4 * lane + 256 * j);
            const f32x4 y = v[j] * rstd * a + b;
            u32x2 o; o.x = pkbf(y[0], y[1]); o.y = pkbf(y[2], y[3]);
            *(u32x2*)(dst + (size_t)row * 1024 + 4 * lane + 256 * j) = o;
        }
    }
}
__device__ __forceinline__ void final_norm_phase(float* io, const float* w) {
    int tid_l = threadIdx.x; asm volatile("" : "+v"(tid_l)); const int tid = tid_l, lane = tid & 63, wave = tid >> 6, G = gridDim.x;
    for (int row = blockIdx.x * NWAVES + wave; row < MX; row += G * NWAVES) {
        float* xr = io + (size_t)row * 1024;
        f32x4 v[4]; float s = 0.f;
#pragma unroll
        for (int j = 0; j < 4; ++j) { v[j] = *(const f32x4*)(xr + 4 * lane + 256 * j); s += (v[j][0] * v[j][0] + v[j][1] * v[j][1]) + (v[j][2] * v[j][2] + v[j][3] * v[j][3]); }
        const float rstd = rsqrtf(wave_sum(s) * (1.0f / 1024.0f) + 1e-6f);
#pragma unroll
        for (int j = 0; j < 4; ++j) { const f32x4 a = *(const f32x4*)(w + 4 * lane + 256 * j); *(f32x4*)(xr + 4 * lane + 256 * j) = v[j] * rstd * a; }
    }
}
__device__ __forceinline__ void norm_h_phase(const float* oh, const float* nw, bf16_t* ya) {
    int tid_l = threadIdx.x; asm volatile("" : "+v"(tid_l)); const int tid = tid_l, lane = tid & 63, wave = tid >> 6, G = gridDim.x;
    for (int row = blockIdx.x * NWAVES + wave; row < MX; row += G * NWAVES) {
        const float* xr = oh + (size_t)row * 1024 + 16 * lane;
        f32x4 v[4]; float s = 0.f;
#pragma unroll
        for (int j = 0; j < 4; ++j) { v[j] = *(const f32x4*)(xr + 4 * j); s += (v[j][0] * v[j][0] + v[j][1] * v[j][1]) + (v[j][2] * v[j][2] + v[j][3] * v[j][3]); }
        s += __shfl_xor(s, 1); s += __shfl_xor(s, 2); s += __shfl_xor(s, 4);
        const float rstd = rsqrtf(s * (1.0f / 128.0f) + 1e-6f);
        u32x4 o[2];
#pragma unroll
        for (int j = 0; j < 4; ++j) { const f32x4 a = *(const f32x4*)(nw + 16 * lane + 4 * j); const f32x4 y = v[j] * rstd * a;
            o[j >> 1][(j & 1) * 2] = pkbf(y[0], y[1]); o[j >> 1][(j & 1) * 2 + 1] = pkbf(y[2], y[3]); }
        *(u32x4*)(ya + (size_t)row * 1024 + 16 * lane) = o[0]; *(u32x4*)(ya + (size_t)row * 1024 + 16 * lane + 8) = o[1];
    }
}
__device__ __forceinline__ void norm_r_phase(const bf16_t* orr, bf16_t* yb) {
    int tid_l = threadIdx.x; asm volatile("" : "+v"(tid_l)); const int tid = tid_l, lane = tid & 63, wave = tid >> 6, G = gridDim.x;
    for (int row = blockIdx.x * NWAVES + wave; row < MX; row += G * NWAVES) {
        const bf16_t* xr = orr + (size_t)row * 2048 + 32 * lane;
        float v[32]; float s = 0.f;
#pragma unroll
        for (int j = 0; j < 4; ++j) { const u32x4 q = *(const u32x4*)(xr + 8 * j);
#pragma unroll
            for (int e = 0; e < 4; ++e) { v[8 * j + 2 * e] = bflo(q[e]); v[8 * j + 2 * e + 1] = bfhi(q[e]); } }
#pragma unroll
        for (int e = 0; e < 32; ++e) s += v[e];
        s += __shfl_xor(s, 1); s += __shfl_xor(s, 2); s += __shfl_xor(s, 4);
        const float mu = s * (1.0f / 256.0f); float q2 = 0.f;
#pragma unroll
        for (int e = 0; e < 32; ++e) { v[e] -= mu; q2 += v[e] * v[e]; }
        q2 += __shfl_xor(q2, 1); q2 += __shfl_xor(q2, 2); q2 += __shfl_xor(q2, 4);
        const float rstd = rsqrtf(q2 * (1.0f / 256.0f) + 1e-5f);
#pragma unroll
        for (int j = 0; j < 4; ++j) { u32x4 o;
#pragma unroll
            for (int e = 0; e < 4; ++e) o[e] = pkbf(v[8 * j + 2 * e] * rstd, v[8 * j + 2 * e + 1] * rstd);
            *(u32x4*)(yb + (size_t)row * 2048 + 32 * lane + 8 * j) = o; }
    }
}

#define MFMA32(a, b, c) __builtin_amdgcn_mfma_f32_32x32x16_bf16((a), (b), (c), 0, 0, 0)
__device__ __forceinline__ int crow(int reg, int h) { return (reg & 3) + 8 * (reg >> 2) + 4 * h; }
__device__ __forceinline__ bf16x8 pack_step(const f32x16& x, int s) {
    u32x4 p; p.x = pkbf(x[8 * s], x[8 * s + 1]); p.y = pkbf(x[8 * s + 2], x[8 * s + 3]); p.z = pkbf(x[8 * s + 4], x[8 * s + 5]); p.w = pkbf(x[8 * s + 6], x[8 * s + 7]);
    return __builtin_bit_cast(bf16x8, p);
}
constexpr int SC_QT = 0, SC_KT = 8704, SC_KTT = 17408, SC_VT = 27648, SC_G = 30208, SC_RED = 30720, SC_DIR_BYTES = 49152;
constexpr int QS = 136, TS = 40, RS = 36;

struct ScanItem {
    const bf16_t* q;
    const unsigned short* kl[2];
    const bf16_t* v; int ldv;
    float lg[2];
    int row_base, nchunk;
    const float* Sin[2]; float* Sout[2]; int ldS;
    float* of32; bf16_t* obf; int ldo;
};

template <int KIND>
__device__ __forceinline__ void scan_item(LAS unsigned char* lds, const ScanItem& a) {
    int tid_l = threadIdx.x; asm volatile("" : "+v"(tid_l)); const int tid = tid_l, dir = tid >> 8, t = tid & 255, w4 = t >> 6, lane = t & 63, r = lane & 31, hh = lane >> 5;
    LAS unsigned char* L = lds + dir * SC_DIR_BYTES;
    LAS bf16_t* QT = (LAS bf16_t*)(L + SC_QT); LAS bf16_t* KT = (LAS bf16_t*)(L + SC_KT);
    LAS bf16_t* KTT = (LAS bf16_t*)(L + SC_KTT); LAS bf16_t* VT = (LAS bf16_t*)(L + SC_VT);
    LAS float* GV = (LAS float*)(L + SC_G); LAS float* RED = (LAS float*)(L + SC_RED);
    const int n = a.nchunk, d = 32 * w4 + r;
    const unsigned short* klp = dir ? a.kl[1] : a.kl[0];
    const float lg = dir ? a.lg[1] : a.lg[0];
    const float* Sin = dir ? a.Sin[1] : a.Sin[0]; float* Sout = dir ? a.Sout[1] : a.Sout[0];
    f32x16 S;
    if (Sin) {
#pragma unroll
        for (int i = 0; i < 16; ++i) S[i] = Sin[(size_t)(32 * w4 + crow(i, hh)) * a.ldS + r];
    } else {
#pragma unroll
        for (int i = 0; i < 16; ++i) S[i] = 0.f;
    }
    unsigned short rq[16], rk[16]; u32x2 rv;
    const int vs = t >> 3, vq = t & 7;
#define LOAD_RAW(jn) do { \
        const int c_ = dir ? n - 1 - (jn) : (jn); \
        const size_t rb_ = (size_t)a.row_base + 32 * c_; \
        _Pragma("unroll") for (int ii = 0; ii < 16; ++ii) { \
            const int i_ = 16 * hh + ii; const size_t row_ = rb_ + (dir ? 31 - i_ : i_); \
            rq[ii] = a.q[row_ * 1024 + d]; \
            rk[ii] = klp[row_ * 1024 + d]; \
        } \
        { const size_t row_ = rb_ + (dir ? 31 - vs : vs); rv = *(const u32x2*)(a.v + row_ * a.ldv + 4 * vq); } \
    } while (0)
    LOAD_RAW(0);
    for (int j = 0; j < n; ++j) {
        {
            float b[16], kk[16];
            if (KIND == 0) {
                float run = 0.f;
#pragma unroll
                for (int ii = 0; ii < 16; ++ii) { const float lf = f16tof(rk[ii]); run += lf; b[ii] = run; kk[ii] = 1.0f - __expf(lf); }
                const float other = __shfl_xor(run, 32);
                const float off = hh ? other : 0.f;
#pragma unroll
                for (int ii = 0; ii < 16; ++ii) b[ii] += off;
                if (hh == 0) GV[d] = __expf(run + other);
            } else {
#pragma unroll
                for (int ii = 0; ii < 16; ++ii) { b[ii] = (float)(16 * hh + ii + 1) * lg; kk[ii] = bf2f(rk[ii]); }
                if (hh == 0) GV[d] = __expf(32.0f * lg);
            }
            unsigned kt[8];
#pragma unroll
            for (int ii = 0; ii < 16; ii += 2) {
                const float e0 = __expf(b[ii]), e1 = __expf(b[ii + 1]);
                const unsigned qq = pkbf(bf2f(rq[ii]) * e0, bf2f(rq[ii + 1]) * e1);
                const unsigned kq = pkbf(kk[ii] * __builtin_amdgcn_rcpf(e0), kk[ii + 1] * __builtin_amdgcn_rcpf(e1));
                kt[ii >> 1] = kq;
                const int i = 16 * hh + ii;
                QT[i * QS + d] = (bf16_t)(qq & 0xffffu); QT[(i + 1) * QS + d] = (bf16_t)(qq >> 16);
                KT[i * QS + d] = (bf16_t)(kq & 0xffffu); KT[(i + 1) * QS + d] = (bf16_t)(kq >> 16);
            }
            *(LAS u32x4*)(KTT + d * TS + 16 * hh) = (u32x4){kt[0], kt[1], kt[2], kt[3]};
            *(LAS u32x4*)(KTT + d * TS + 16 * hh + 8) = (u32x4){kt[4], kt[5], kt[6], kt[7]};
            VT[(4 * vq + 0) * TS + vs] = (bf16_t)(rv.x & 0xffffu); VT[(4 * vq + 1) * TS + vs] = (bf16_t)(rv.x >> 16);
            VT[(4 * vq + 2) * TS + vs] = (bf16_t)(rv.y & 0xffffu); VT[(4 * vq + 3) * TS + vs] = (bf16_t)(rv.y >> 16);
        }
        __syncthreads();
        if (j + 1 < n) LOAD_RAW(j + 1);
        {
            f32x16 at;
#pragma unroll
            for (int i = 0; i < 16; ++i) at[i] = 0.f;
#pragma unroll
            for (int ks = 0; ks < 2; ++ks) {
                const bf16x8 ka = *(const LAS bf16x8*)(KT + r * QS + 32 * w4 + 16 * ks + 8 * hh);
                const bf16x8 qb = *(const LAS bf16x8*)(QT + r * QS + 32 * w4 + 16 * ks + 8 * hh);
                at = MFMA32(ka, qb, at);
            }
#pragma unroll
            for (int i = 0; i < 16; ++i) if (crow(i, hh) > r) at[i] = 0.f;
            f32x16 o;
#pragma unroll
            for (int i = 0; i < 16; ++i) o[i] = 0.f;
#pragma unroll
            for (int ks = 0; ks < 2; ++ks) {
                const bf16x8 pa = pack_step(at, ks);
                const s16x4 vlo = *(const LAS s16x4*)(VT + r * TS + 16 * ks + 4 * hh), vhi = *(const LAS s16x4*)(VT + r * TS + 16 * ks + 8 + 4 * hh);
                const bf16x8 vb = __builtin_shufflevector(vlo, vhi, 0, 1, 2, 3, 4, 5, 6, 7);
                o = MFMA32(pa, vb, o);
                const s16x4 qlo = *(const LAS s16x4*)(QT + r * QS + 32 * w4 + 16 * ks + 4 * hh), qhi = *(const LAS s16x4*)(QT + r * QS + 32 * w4 + 16 * ks + 8 + 4 * hh);
                const bf16x8 qa = __builtin_shufflevector(qlo, qhi, 0, 1, 2, 3, 4, 5, 6, 7);
                const bf16x8 sb = pack_step(S, ks);
                o = MFMA32(qa, sb, o);
            }
            if (a.of32 || a.obf) {
#pragma unroll
                for (int i = 0; i < 16; ++i) RED[(w4 * 32 + crow(i, hh)) * RS + r] = o[i];
            }
#pragma unroll
            for (int ks = 0; ks < 2; ++ks) {
                const bf16x8 ka = *(const LAS bf16x8*)(KTT + (32 * w4 + r) * TS + 16 * ks + 8 * hh);
                const bf16x8 vb = *(const LAS bf16x8*)(VT + r * TS + 16 * ks + 8 * hh);
                S = MFMA32(ka, vb, S);
            }
#pragma unroll
            for (int g = 0; g < 4; ++g) { const f32x4 gv = *(const LAS f32x4*)(GV + 32 * w4 + 8 * g + 4 * hh);
#pragma unroll
                for (int jj = 0; jj < 4; ++jj) S[4 * g + jj] *= gv[jj]; }
        }
        __syncthreads();
        if (a.of32 || a.obf) {
            const int og = dir;
            const int clo = j < n - 1 - j ? j : n - 1 - j, chi = n - 1 - clo;
            const int c = og ? chi : clo;
            const int sd = (c == j) ? 0 : 1;
            const bool second = j >= (n >> 1);
            const int tt = t >> 3, cq = t & 7, li = sd ? 31 - tt : tt;
            const LAS float* R0 = (const LAS float*)(lds + sd * SC_DIR_BYTES + SC_RED) + li * RS + 4 * cq;
            f32x4 sum = *(const LAS f32x4*)R0 + *(const LAS f32x4*)(R0 + 32 * RS) + *(const LAS f32x4*)(R0 + 64 * RS) + *(const LAS f32x4*)(R0 + 96 * RS);
            const size_t row = (size_t)a.row_base + 32 * c + tt;
            if (KIND == 0) {
                float* p = a.of32 + row * a.ldo + 4 * cq;
                if (second) sum += *(const f32x4*)p;
                *(f32x4*)p = sum;
            } else {
                bf16_t* p = a.obf + row * a.ldo + 4 * cq;
                if (second) { const u32x2 old = *(const u32x2*)p; sum[0] += bflo(old.x); sum[1] += bfhi(old.x); sum[2] += bflo(old.y); sum[3] += bfhi(old.y); }
                u32x2 w; w.x = pkbf(sum[0], sum[1]); w.y = pkbf(sum[2], sum[3]); *(u32x2*)p = w;
            }
        }
    }
    if (Sout) {
#pragma unroll
        for (int i = 0; i < 16; ++i) Sout[(size_t)(32 * w4 + crow(i, hh)) * a.ldS + r] = S[i];
    }
    __syncthreads();
}

__device__ __forceinline__ float log_sigmoid_(float th) { return -log1pf(expf(-th)); }

__device__ __forceinline__ void scan_phase(const Params& P, LAS unsigned char* lds, int kind, bool ctx) {
    unsigned char* ws = P.ws;
    bf16_t* SCR = (bf16_t*)(ws + WS_SCR);
    const int nitems = kind == 0 ? 64 : 128;
    for (int it = blockIdx.x; it < nitems; it += gridDim.x) {
        ScanItem a;
        if (kind == 0) {
            const int bh = it >> 2, cb = it & 3, b = bh >> 3, h = bh & 7;
            a.q = SCR + 128 * h;
            a.kl[0] = (const unsigned short*)(SCR + SLOT_ELEMS) + 128 * h; a.kl[1] = (const unsigned short*)(SCR + 2 * SLOT_ELEMS) + 128 * h;
            a.v = SCR + 3 * SLOT_ELEMS + 128 * h + 32 * cb; a.ldv = 1024; a.lg[0] = 0.f; a.lg[1] = 0.f;
            float* cs = (float*)(ws + WS_CSH);
            float* s0 = cs + ((size_t)(0 * 2 + b) * 8 + h) * 128 * 128 + 32 * cb; float* s1 = cs + ((size_t)(1 * 2 + b) * 8 + h) * 128 * 128 + 32 * cb;
            a.ldS = 128;
            if (ctx) { a.row_base = MX + b * CTXL; a.nchunk = CTXL / 32; a.Sin[0] = nullptr; a.Sin[1] = nullptr; a.Sout[0] = s0; a.Sout[1] = s1; a.of32 = nullptr; a.obf = nullptr; a.ldo = 0; }
            else { a.row_base = b * SEQ; a.nchunk = SEQ / 32; a.Sin[0] = s0; a.Sin[1] = s1; a.Sout[0] = nullptr; a.Sout[1] = nullptr; a.of32 = P.out + 128 * h + 32 * cb; a.obf = nullptr; a.ldo = 1024; }
            scan_item<0>(lds, a);
        } else {
            const int bh = it >> 3, cb = it & 7, b = bh >> 3, h = bh & 7;
            a.q = SCR + 128 * h;
            a.kl[0] = (const unsigned short*)(SCR + SLOT_ELEMS) + 128 * h; a.kl[1] = a.kl[0];
            a.v = SCR + 2 * SLOT_ELEMS + 256 * h + 32 * cb; a.ldv = 2048;
            a.lg[0] = log_sigmoid_(P.in[12][h]); a.lg[1] = log_sigmoid_(P.in[13][h]);
            float* cs = (float*)(ws + WS_CSR);
            float* s0 = cs + ((size_t)(0 * 2 + b) * 8 + h) * 128 * 256 + 32 * cb; float* s1 = cs + ((size_t)(1 * 2 + b) * 8 + h) * 128 * 256 + 32 * cb;
            a.ldS = 256;
            if (ctx) { a.row_base = MX + b * CTXL; a.nchunk = CTXL / 32; a.Sin[0] = nullptr; a.Sin[1] = nullptr; a.Sout[0] = s0; a.Sout[1] = s1; a.of32 = nullptr; a.obf = nullptr; a.ldo = 0; }
            else { a.row_base = b * SEQ; a.nchunk = SEQ / 32; a.Sin[0] = s0; a.Sin[1] = s1; a.Sout[0] = nullptr; a.Sout[1] = nullptr; a.of32 = nullptr; a.obf = (bf16_t*)P.out + 256 * h + 32 * cb; a.ldo = 2048; }
            scan_item<1>(lds, a);
        }
    }
}

template <int MODE>
__device__ __forceinline__ void run_gemm(LAS unsigned char* lds, const bf16_t* A, const bf16_t* Bt, int M, int N, int K, const Params& P) {
    pg8::Gemm g{A, Bt, M, N, K}; pg8::StaticOrder S; S.init(M, N, (int)gridDim.x, (int)blockIdx.x);
    EpiAll<MODE> E; E.ws = P.ws; E.x = P.in[0]; E.out = P.out;
    pg8::gemm_phase<EpiAll<MODE>, pg8::StaticOrder, true, true>(lds, g, S, E);
}

__global__ void __launch_bounds__(NTHREADS, 2) mk_fwd(Params P) {
    extern __shared__ __attribute__((aligned(16))) unsigned char lds_raw[];
    LAS unsigned char* lds = (LAS unsigned char*)lds_raw;
    cg::grid_group grid = cg::this_grid();
    unsigned char* ws = P.ws;
    bf16_t* W_IN = (bf16_t*)(ws + WS_W_IN); bf16_t* HX = (bf16_t*)(ws + WS_HX); bf16_t* YA = (bf16_t*)(ws + WS_YA); bf16_t* SCR = (bf16_t*)(ws + WS_SCR);

    p0_phase(P, lds);
    grid.sync();
    norm_mod_phase(P.in[0], P.in[2], MT, HX, P.in[6], (const float*)(ws + WS_MODP), 8, P.in[5], 0, 1024, lds);
    {
        float* modf_ = (float*)(ws + WS_MODF); const float* modp = (const float*)(ws + WS_MODP);
        const int idx = blockIdx.x * NTHREADS + threadIdx.x;
        for (int i = idx; i < 3 * 6144; i += gridDim.x * NTHREADS) { const int r = i / 6144, jx = i % 6144; float s = P.in[5][jx];
            for (int p = 0; p < 8; ++p) s += modp[(size_t)(p * 3 + r) * 6144 + jx];
            modf_[i] = s; }
    }
    grid.sync();
    run_gemm<1>(lds, HX, W_IN, MT, 4096, 1024, P);
    grid.sync();
    scan_phase(P, lds, 0, true);
    grid.sync();
    scan_phase(P, lds, 0, false);
    grid.sync();
    norm_h_phase(P.out, P.in[11], YA);
    grid.sync();
    run_gemm<2>(lds, HX, W_IN + (size_t)4096 * 1024, MT, 4096, 1024, P);
    grid.sync();
    scan_phase(P, lds, 1, true);
    grid.sync();
    scan_phase(P, lds, 1, false);
    grid.sync();
    norm_r_phase((const bf16_t*)P.out, SCR);
    grid.sync();
    run_gemm<3>(lds, HX, W_IN + (size_t)8192 * 1024, MX, 5120, 1024, P);
    grid.sync();
    run_gemm<4>(lds, YA, (const bf16_t*)(ws + WS_W_PA), MX, 1024, 1024, P);
    run_gemm<5>(lds, SCR, (const bf16_t*)(ws + WS_W_PB), MX, 1024, 2048, P);
    grid.sync();
    run_gemm<6>(lds, HX, (const bf16_t*)(ws + WS_W_OUT), MX, 1024, 1024, P);
    grid.sync();
    norm_mod_phase(P.out, nullptr, MX, YA, P.in[7], (const float*)(ws + WS_MODF), 1, nullptr, 3072, 4096, lds);
    grid.sync();
    run_gemm<7>(lds, YA, (const bf16_t*)(ws + WS_W_GU), MX, 5632, 1024, P);
    grid.sync();
    run_gemm<8>(lds, SCR, (const bf16_t*)(ws + WS_W_DN), MX, 1024, DFF, P);
    grid.sync();
    final_norm_phase(P.out, P.in[20]);
}

extern "C" void kernel_launch(void* const* d_in, const int* in_sizes, int n_in, void* d_out, int out_size, void* d_ws, size_t ws_size, hipStream_t stream) {
    static int grid_blocks = 0;
    if (grid_blocks == 0) {
        if (n_in != 21 || ws_size < WS_END) { fprintf(stderr, "kernel_launch: unexpected n_in %d / ws_size %zu (need %zu)\n", n_in, ws_size, (size_t)WS_END); grid_blocks = -1; return; }
        int dev = 0, cus = 0, per_cu = 0;
        hipGetDevice(&dev);
        hipDeviceGetAttribute(&cus, hipDeviceAttributeMultiprocessorCount, dev);
        hipFuncSetAttribute((const void*)mk_fwd, hipFuncAttributeMaxDynamicSharedMemorySize, LDS_BYTES);
        hipOccupancyMaxActiveBlocksPerMultiprocessor(&per_cu, (const void*)mk_fwd, NTHREADS, LDS_BYTES);
        if (per_cu < 1) per_cu = 1;
        grid_blocks = cus * per_cu;
        (void)hipGetLastError();
    }
    if (grid_blocks < 0) return;
    Params p{};
    for (int i = 0; i < 21; ++i) p.in[i] = (const float*)d_in[i];
    p.out = (float*)d_out; p.ws = (unsigned char*)d_ws;
    void* args[] = {&p};
    hipError_t e = hipLaunchCooperativeKernel((const void*)mk_fwd, dim3(grid_blocks), dim3(NTHREADS), args, LDS_BYTES, stream);
    if (e != hipSuccess) fprintf(stderr, "cooperative launch failed: %s (grid %d)\n", hipGetErrorString(e), grid_blocks);
}
```

```cpp
#include <hip/hip_runtime.h>
#include <hip/hip_cooperative_groups.h>
#include <cstdio>
#include <cstdint>
namespace cg = cooperative_groups;
namespace pg8 {
#define PG8_LAS __attribute__((address_space(3)))
typedef unsigned short bf16_t;
typedef short bf16x8 __attribute__((ext_vector_type(8)));
typedef float f32x4 __attribute__((ext_vector_type(4)));
typedef unsigned u32x4 __attribute__((ext_vector_type(4)));
constexpr int BM = 256, BK = 64, HALF = 128, HTB = HALF * BK * 2  , STAGE_BYTES = 8 * HTB, NXCD = 8, WGM = 8;

__host__ __device__ __forceinline__ int lds_byte(int r, int c) { const int st = (r >> 4) * 2 + (c >> 5), rr = r & 15, cc = c & 31, ob = rr * 64 + cc * 2; return st * 1024 + (ob ^ (((ob >> 9) & 1) << 5)); }
__host__ __device__ __forceinline__ void stage_rc(int b, int& R, int& C) { const int st = b / 1024, sb = b % 1024, swz = sb ^ (((sb >> 9) & 1) << 5); R = (st >> 1) * 16 + swz / 64; C = (st & 1) * 32 + (swz % 64) / 2; }
__host__ __device__ __forceinline__ int perm32(int rho) { const int n = rho >> 4, i = rho & 15; return 8 * (i >> 2) + 4 * n + (i & 3); }

struct Unit { int pm, pn; };
struct Gemm { const bf16_t* A; const bf16_t* Bt; int M, N, K; };

struct StaticOrder {
    int nM, nN, nwg, G, c;
    __host__ __device__ void init(int M, int N, int G_, int c_) { nM = M / BM; nN = N / BM; nwg = nM * nN; G = G_; c = c_; }
    __host__ __device__ bool next(int i, Unit& u) const {
        const long L = (long)i * G + c; if (L >= nwg) return false;
        int wgid = (int)L; { const int q = nwg / NXCD, r = nwg % NXCD, xcd = wgid % NXCD, off = wgid / NXCD; wgid = (xcd < r ? xcd * (q + 1) : r * (q + 1) + (xcd - r) * q) + off; }
        const int nig = WGM * nN, gid = wgid / nig, fm = gid * WGM, gsz = (nM - fm) < WGM ? (nM - fm) : WGM;
        u.pm = fm + ((wgid % nig) % gsz); u.pn = (wgid % nig) / gsz; return true;
    }
    __device__ __forceinline__ void a_ready(const Unit&) const {}
    __device__ __forceinline__ void done(const Unit&) const {}
};

__device__ __forceinline__ unsigned cvt_pk_bf16(float lo, float hi) { unsigned r; asm volatile("v_cvt_pk_bf16_f32 %0, %1, %2" : "=v"(r) : "v"(lo), "v"(hi)); return r; }
typedef float f32x2 __attribute__((ext_vector_type(2)));
template <class Epi, class Sched, bool ALIGN_EPI = false, bool SP2 = false>
__device__ __forceinline__ void gemm_phase(PG8_LAS unsigned char* lds, const Gemm g, const Sched& S, const Epi& E) {
    int tid_l = threadIdx.x; asm volatile("" : "+v"(tid_l));
    const int tid = tid_l, wid = __builtin_amdgcn_readfirstlane(tid >> 6), lane = tid & 63, wr = wid >> 2, wc = wid & 3, fr = lane & 15, fq = lane >> 4;
    const int K = g.K, nt = K / BK;
    unsigned voffA[2], voffB[2];
#pragma unroll
    for (int i = 0; i < 2; ++i) { int R, C; stage_rc(tid * 16 + i * 8192, R, C); const int Rb = Epi::PERM ? ((R & ~31) + perm32(R & 31)) : R;
        voffA[i] = (unsigned)(R * K + C) * 2u; voffB[i] = (unsigned)(Rb * K + C) * 2u; }
    const size_t kstep = (size_t)(BK * 2);
    const size_t hstep = (size_t)HALF * K * 2;
    const size_t tstep = 2 * hstep;
    const unsigned ldsw = (unsigned)wid * 1024u;
    const int aoff = lds_byte(wr * 64 + fr, fq * 8), boff = lds_byte(wc * 32 + fr, fq * 8);
#define PG8_SA(b, h) (((b) * 2 + (h)) * HTB)
#define PG8_SB(b, h) ((4 + (b) * 2 + (h)) * HTB)
#define PG8_STAGE(bufoff, gbase, voff) do { _Pragma("unroll") for (int _i = 0; _i < 2; ++_i) \
        __builtin_amdgcn_global_load_lds((const unsigned*)((const char*)(gbase) + (voff)[_i]), (PG8_LAS unsigned*)(lds + (bufoff) + ldsw + _i * 8192), 16, 0, 0); } while (0)
#define PG8_LDA(dst, b, h) do { _Pragma("unroll") for (int m = 0; m < 4; ++m) _Pragma("unroll") for (int k = 0; k < 2; ++k) dst[m][k] = *(const PG8_LAS bf16x8*)(lds + PG8_SA(b, h) + aoff + m * 2048 + k * 1024); } while (0)
#define PG8_LDB(dst, b, h) do { _Pragma("unroll") for (int n = 0; n < 2; ++n) _Pragma("unroll") for (int k = 0; k < 2; ++k) dst[n][k] = *(const PG8_LAS bf16x8*)(lds + PG8_SB(b, h) + boff + n * 2048 + k * 1024); } while (0)
#define PG8_MMA(ai, bj, At, Bt) do { __builtin_amdgcn_s_setprio(1); _Pragma("unroll") for (int m = 0; m < 4; ++m) _Pragma("unroll") for (int n = 0; n < 2; ++n) _Pragma("unroll") for (int k = 0; k < 2; ++k) \
        acc[ai][bj][m][n] = __builtin_amdgcn_mfma_f32_16x16x32_bf16(Bt[n][k], At[m][k], acc[ai][bj][m][n], 0, 0, 0); __builtin_amdgcn_s_setprio(0); } while (0)
#define PG8_WAIT_V(n) asm volatile("s_waitcnt vmcnt(" #n ")" ::: "memory")
#define PG8_WAIT_L(n) asm volatile("s_waitcnt lgkmcnt(" #n ")" ::: "memory")
#define PG8_BAR __builtin_amdgcn_s_barrier()
#define PG8_SCHED __builtin_amdgcn_sched_barrier(0)
    Unit cur, nxt; int ui = 0;
    if (!S.next(0, cur)) return;
    f32x4 acc[2][2][4][2];
#pragma unroll
    for (int a = 0; a < 2; ++a)
#pragma unroll
        for (int b = 0; b < 2; ++b)
#pragma unroll
            for (int m = 0; m < 4; ++m)
#pragma unroll
                for (int n = 0; n < 2; ++n) acc[a][b][m][n] = (f32x4){0.f, 0.f, 0.f, 0.f};
    bf16x8 At[4][2], B0[2][2], B1[2][2];
    const char* cA = (const char*)g.A + (size_t)cur.pm * tstep; const char* cB = (const char*)g.Bt + (size_t)cur.pn * tstep;
    S.a_ready(cur);
    if constexpr (SP2) {
        PG8_STAGE(PG8_SB(0, 0), cB, voffB); PG8_STAGE(PG8_SB(0, 1), cB + hstep, voffB); PG8_STAGE(PG8_SA(0, 0), cA, voffA); PG8_STAGE(PG8_SA(0, 1), cA + hstep, voffA);
        if (wr == 1) PG8_BAR;
        PG8_WAIT_V(2); PG8_BAR;
        PG8_STAGE(PG8_SB(1, 0), cB + kstep, voffB); PG8_STAGE(PG8_SA(1, 0), cA + kstep, voffA); PG8_STAGE(PG8_SB(1, 1), cB + hstep + kstep, voffB);
        PG8_WAIT_V(6); PG8_BAR;
    } else {
        PG8_STAGE(PG8_SB(0, 0), cB, voffB); PG8_STAGE(PG8_SA(0, 0), cA, voffA); PG8_STAGE(PG8_SB(0, 1), cB + hstep, voffB); PG8_STAGE(PG8_SA(0, 1), cA + hstep, voffA);
        if (wr == 1) PG8_BAR;
        PG8_WAIT_V(4); PG8_BAR;
        PG8_STAGE(PG8_SB(1, 0), cB + kstep, voffB); PG8_STAGE(PG8_SA(1, 0), cA + kstep, voffA); PG8_STAGE(PG8_SB(1, 1), cB + hstep + kstep, voffB);
        PG8_WAIT_V(6); PG8_BAR;
    }
    for (;;) {
        const bool has_next = S.next(ui + 1, nxt);
        const char* nA = has_next ? (const char*)g.A + (size_t)nxt.pm * tstep : cA; const char* nB = has_next ? (const char*)g.Bt + (size_t)nxt.pn * tstep : cB;
        for (int t = 0; t < nt; t += 2) {
            const bool last = (t == nt - 2);
            const char* a1 = cA + (size_t)(t + 1) * kstep;
            const char* a2 = last ? nA : cA + (size_t)(t + 2) * kstep; const char* b2 = last ? nB : cB + (size_t)(t + 2) * kstep;
            const char* a3 = a2 + kstep; const char* b3 = b2 + kstep;
            if (last && has_next) S.a_ready(nxt);
            if constexpr (SP2) {
            PG8_LDB(B0, 0, 0); PG8_LDB(B1, 0, 1); PG8_SCHED; PG8_LDA(At, 0, 0); PG8_STAGE(PG8_SA(1, 1), a1 + hstep, voffA);
            PG8_WAIT_V(8); PG8_WAIT_L(0); PG8_BAR; PG8_MMA(0, 0, At, B0); PG8_MMA(0, 1, At, B1); PG8_BAR; PG8_SCHED;
            PG8_LDA(At, 0, 1); PG8_STAGE(PG8_SB(0, 0), b2, voffB); PG8_STAGE(PG8_SB(0, 1), b2 + hstep, voffB); PG8_STAGE(PG8_SA(0, 0), a2, voffA);
            PG8_WAIT_V(8); PG8_WAIT_L(0); PG8_BAR; PG8_MMA(1, 0, At, B0); PG8_MMA(1, 1, At, B1); PG8_BAR; PG8_SCHED;
            PG8_LDB(B0, 1, 0); PG8_LDB(B1, 1, 1); PG8_SCHED; PG8_LDA(At, 1, 0); PG8_STAGE(PG8_SA(0, 1), a2 + hstep, voffA);
            PG8_WAIT_V(8); PG8_WAIT_L(0); PG8_BAR; PG8_MMA(0, 0, At, B0); PG8_MMA(0, 1, At, B1); PG8_BAR; PG8_SCHED;
            PG8_LDA(At, 1, 1); PG8_STAGE(PG8_SB(1, 0), b3, voffB); PG8_STAGE(PG8_SB(1, 1), b3 + hstep, voffB); PG8_STAGE(PG8_SA(1, 0), a3, voffA);
            PG8_WAIT_V(8); PG8_WAIT_L(0); PG8_BAR; PG8_MMA(1, 0, At, B0); PG8_MMA(1, 1, At, B1); PG8_BAR; PG8_SCHED;
            } else {
            PG8_LDB(B0, 0, 0); PG8_SCHED; PG8_LDA(At, 0, 0); PG8_STAGE(PG8_SA(1, 1), a1 + hstep, voffA);
            PG8_WAIT_L(8); PG8_BAR; PG8_WAIT_L(0); PG8_MMA(0, 0, At, B0); PG8_BAR; PG8_SCHED;
            PG8_LDB(B1, 0, 1); PG8_STAGE(PG8_SB(0, 0), b2, voffB);
            PG8_BAR; PG8_WAIT_L(0); PG8_MMA(0, 1, At, B1); PG8_BAR;
            PG8_LDA(At, 0, 1); PG8_STAGE(PG8_SA(0, 0), a2, voffA);
            PG8_BAR; PG8_WAIT_L(0); PG8_MMA(1, 0, At, B0); PG8_BAR; PG8_SCHED;
            PG8_STAGE(PG8_SB(0, 1), b2 + hstep, voffB);
            PG8_WAIT_V(6); PG8_BAR; PG8_MMA(1, 1, At, B1); PG8_BAR;
            PG8_LDB(B0, 1, 0); PG8_SCHED; PG8_LDA(At, 1, 0); PG8_STAGE(PG8_SA(0, 1), a2 + hstep, voffA);
            PG8_WAIT_L(8); PG8_BAR; PG8_WAIT_L(0); PG8_MMA(0, 0, At, B0); PG8_BAR; PG8_SCHED;
            PG8_LDB(B1, 1, 1); PG8_STAGE(PG8_SB(1, 0), b3, voffB);
            PG8_BAR; PG8_WAIT_L(0); PG8_MMA(0, 1, At, B1); PG8_BAR;
            PG8_LDA(At, 1, 1); PG8_STAGE(PG8_SA(1, 0), a3, voffA);
            PG8_BAR; PG8_WAIT_L(0); PG8_MMA(1, 0, At, B0); PG8_BAR; PG8_SCHED;
            PG8_STAGE(PG8_SB(1, 1), b3 + hstep, voffB);
            PG8_WAIT_V(6); PG8_BAR; PG8_MMA(1, 1, At, B1); PG8_BAR;
            }
        }
        if constexpr (ALIGN_EPI) { if (wr == 0) PG8_BAR; }
        if constexpr (!Epi::AFTER_DRAIN) { E(acc, cur, wr, wc, fr, fq); S.done(cur); }
        if (!has_next) break;
#pragma unroll
        for (int a = 0; a < 2; ++a)
#pragma unroll
            for (int b = 0; b < 2; ++b)
#pragma unroll
                for (int m = 0; m < 4; ++m)
#pragma unroll
                    for (int n = 0; n < 2; ++n) acc[a][b][m][n] = (f32x4){0.f, 0.f, 0.f, 0.f};
        cur = nxt; cA = nA; cB = nB; ++ui;
        if constexpr (ALIGN_EPI) { if (wr == 1) PG8_BAR; }
    }
    PG8_WAIT_V(0);
    if constexpr (!ALIGN_EPI) { if (wr == 0) PG8_BAR; }
    PG8_BAR;
    if constexpr (Epi::AFTER_DRAIN) { E.fused(acc, cur, wr, wc, fr, fq, lds, wid, lane); S.done(cur); }
#undef PG8_SA
#undef PG8_SB
#undef PG8_STAGE
#undef PG8_LDA
#undef PG8_LDB
#undef PG8_MMA
#undef PG8_WAIT_V
#undef PG8_WAIT_L
#undef PG8_BAR
#undef PG8_SCHED
}
}

#define LAS __attribute__((address_space(3)))
typedef unsigned short bf16_t;
typedef short bf16x8 __attribute__((ext_vector_type(8)));
typedef short s16x4 __attribute__((ext_vector_type(4)));
typedef float f32x4 __attribute__((ext_vector_type(4)));
typedef float f32x2 __attribute__((ext_vector_type(2)));
typedef float f32x16 __attribute__((ext_vector_type(16)));
typedef unsigned u32x4 __attribute__((ext_vector_type(4)));
typedef unsigned u32x2 __attribute__((ext_vector_type(2)));
typedef __bf16 bf16x2_t __attribute__((ext_vector_type(2)));
typedef _Float16 f16x2_t __attribute__((ext_vector_type(2)));

constexpr int DM = 1024, NBATCH = 2, SEQ = 8192, CTXL = 256;
constexpr int MX = NBATCH * SEQ;
constexpr int MC = NBATCH * CTXL;
constexpr int MT = MX + MC;
constexpr int DFF = 2816;
constexpr int NTHREADS = 512, NWAVES = 8;
constexpr int LDS_BYTES = 4 * 36864 + 1024;

constexpr size_t SLOT_ELEMS = (size_t)MT * 1024;
constexpr size_t WS_W_R12 = 0;
constexpr size_t WS_W_GU  = WS_W_R12 + (size_t)8192 * 1024 * 2;
constexpr size_t WS_W_DN  = WS_W_GU  + (size_t)5632 * 1024 * 2;
constexpr size_t WS_W_R3  = WS_W_DN  + (size_t)1024 * 2816 * 2;
constexpr size_t WS_W_PA  = WS_W_R3  + (size_t)5120 * 1024 * 2;
constexpr size_t WS_W_PB  = WS_W_PA  + (size_t)1024 * 1024 * 2;
constexpr size_t WS_W_OUT = WS_W_PB  + (size_t)1024 * 2048 * 2;
constexpr size_t WS_HX    = WS_W_OUT + (size_t)1024 * 1024 * 2;
constexpr size_t WS_YA    = WS_HX    + SLOT_ELEMS * 2;
constexpr size_t WS_SCR   = WS_YA    + (size_t)MX * 1024 * 2;
constexpr size_t WS_MODP  = WS_SCR   + 4 * SLOT_ELEMS * 2;
constexpr size_t WS_MODF  = WS_MODP  + (size_t)8 * 3 * 6144 * 4;
constexpr size_t WS_LBV   = WS_MODF  + (size_t)3 * 6144 * 4;
constexpr size_t WS_ROPE  = WS_LBV   + (size_t)2 * 1024 * 4;
constexpr size_t WS_CSH   = WS_ROPE  + (size_t)(4096 + 4096 + 2048 + 2048) * 4;
constexpr size_t WS_CSR   = WS_CSH   + (size_t)2 * 2 * 8 * 128 * 128 * 4;
constexpr size_t WS_GSUM  = WS_CSR   + (size_t)2 * 2 * 8 * 128 * 256 * 4;
constexpr size_t WS_END   = WS_GSUM  + (size_t)16 * 2 * 16 * 128 * 4;
static_assert(WS_W_R3 - WS_W_R12 >= (size_t)32 * 2 * 8 * 16384 * 4, "retention segment states must fit");

struct Params { const float* in[21]; float* out; unsigned char* ws; };

__device__ __forceinline__ unsigned pkbf(float lo, float hi) { f32x2 v = {lo, hi}; bf16x2_t b = __builtin_convertvector(v, bf16x2_t); return __builtin_bit_cast(unsigned, b); }
__device__ __forceinline__ unsigned pkf16(float lo, float hi) { f32x2 v = {lo, hi}; f16x2_t b = __builtin_convertvector(v, f16x2_t); return __builtin_bit_cast(unsigned, b); }
__device__ __forceinline__ float bf2f(unsigned short u) { return __builtin_bit_cast(float, (unsigned)u << 16); }
__device__ __forceinline__ float bflo(unsigned u) { return __builtin_bit_cast(float, u << 16); }
__device__ __forceinline__ float bfhi(unsigned u) { return __builtin_bit_cast(float, u & 0xffff0000u); }
__device__ __forceinline__ float f16tof(unsigned short u) { return (float)__builtin_bit_cast(_Float16, u); }
__device__ __forceinline__ float sigmoidf_(float z) { return __builtin_amdgcn_rcpf(1.0f + __expf(-z)); }
__device__ __forceinline__ float siluf_(float z) { return z * sigmoidf_(z); }
__device__ __forceinline__ float wave_sum(float v) {
#pragma unroll
    for (int o = 1; o < 64; o <<= 1) v += __shfl_xor(v, o);
    return v;
}
#define LDS_WAIT() asm volatile("s_waitcnt lgkmcnt(0)" ::: "memory")

template <int mode> struct EpiAll {
    static constexpr bool PERM = true, AFTER_DRAIN = false;
    unsigned char* ws; const float* x; float* out;
    __device__ __forceinline__ void store8(bf16_t* p, const f32x4& a, const f32x4& b) const {
        u32x4 w; w.x = pkbf(a[0], a[1]); w.y = pkbf(a[2], a[3]); w.z = pkbf(b[0], b[1]); w.w = pkbf(b[2], b[3]); *(u32x4*)p = w;
    }
    __device__ __forceinline__ void operator()(const f32x4 (&acc)[2][2][4][2], const pg8::Unit& u, int wr, int wc, int fr, int fq) const {
        const int row0 = u.pm * 256 + wr * 64 + fr;
        const int cin = wc * 32 + 8 * fq;
        bf16_t* SCR = (bf16_t*)(ws + WS_SCR);
        if (mode == 1) {
            const int seg = u.pn >> 2, col0 = (u.pn & 3) * 256 + cin;
            bf16_t* base = SCR + (size_t)seg * SLOT_ELEMS;
            if (seg == 1 || seg == 2) {
                const float* lbv = (const float*)(ws + WS_LBV) + (seg - 1) * 1024;
#pragma unroll
                for (int bj = 0; bj < 2; ++bj) {
                    const f32x4 l0 = *(const f32x4*)(lbv + col0 + bj * 128), l1 = *(const f32x4*)(lbv + col0 + bj * 128 + 4);
#pragma unroll
                    for (int ai = 0; ai < 2; ++ai)
#pragma unroll
                        for (int m = 0; m < 4; ++m) {
                            float v[8];
#pragma unroll
                            for (int j = 0; j < 4; ++j) {
                                const float z0 = acc[ai][bj][m][0][j], z1 = acc[ai][bj][m][1][j];
                                v[j] = __logf(l0[j] + (1.0f - l0[j]) * sigmoidf_(z0));
                                v[4 + j] = __logf(l1[j] + (1.0f - l1[j]) * sigmoidf_(z1));
                            }
                            u32x4 w; w.x = pkf16(v[0], v[1]); w.y = pkf16(v[2], v[3]); w.z = pkf16(v[4], v[5]); w.w = pkf16(v[6], v[7]);
                            *(u32x4*)(base + (size_t)(row0 + ai * 128 + m * 16) * 1024 + col0 + bj * 128) = w;
                        }
                }
            } else {
                const float sc = seg == 0 ? 0.08838834764831845f : 1.0f;
#pragma unroll
                for (int ai = 0; ai < 2; ++ai)
#pragma unroll
                    for (int m = 0; m < 4; ++m)
#pragma unroll
                        for (int bj = 0; bj < 2; ++bj)
                            store8(base + (size_t)(row0 + ai * 128 + m * 16) * 1024 + col0 + bj * 128, acc[ai][bj][m][0] * sc, acc[ai][bj][m][1] * sc);
            }
        } else if (mode == 2) {
            if (u.pn < 8) {
                const int seg = u.pn >> 2, tile = u.pn & 3;
                bf16_t* base = SCR + (size_t)seg * SLOT_ELEMS;
                const float sc = seg == 0 ? 0.08838834764831845f : 1.0f;
                const int head = 2 * tile + (cin >> 6), e = cin & 63;
                const float* rp = (const float*)(ws + WS_ROPE);
                const bool latent = u.pm < 64;
#pragma unroll
                for (int ai = 0; ai < 2; ++ai)
#pragma unroll
                    for (int m = 0; m < 4; ++m) {
                        const int row = row0 + ai * 128 + m * 16;
                        f32x4 c0 = {1.f, 1.f, 1.f, 1.f}, c1 = c0, s0 = {0.f, 0.f, 0.f, 0.f}, s1 = s0;
                        if (latent) {
                            const int pos = row & (SEQ - 1), prow = pos >> 6, pcol = pos & 63;
                            const float* cp = e < 32 ? rp + prow * 32 + e : rp + 8192 + pcol * 32 + (e - 32);
                            const float* sp = e < 32 ? rp + 4096 + prow * 32 + e : rp + 8192 + 2048 + pcol * 32 + (e - 32);
                            c0 = *(const f32x4*)cp; c1 = *(const f32x4*)(cp + 4); s0 = *(const f32x4*)sp; s1 = *(const f32x4*)(sp + 4);
                        }
                        const f32x4 a0 = acc[ai][0][m][0] * sc, a1 = acc[ai][0][m][1] * sc, b0 = acc[ai][1][m][0] * sc, b1 = acc[ai][1][m][1] * sc;
                        bf16_t* p = base + (size_t)row * 1024 + head * 128 + e;
                        store8(p, a0 * c0 - b0 * s0, a1 * c1 - b1 * s1);
                        store8(p + 64, a0 * s0 + b0 * c0, a1 * s1 + b1 * c1);
                        asm volatile("" ::: "memory");
                    }
            } else {
                bf16_t* base = SCR + 2 * SLOT_ELEMS;
                const int col0 = (u.pn - 8) * 256 + cin;
#pragma unroll
                for (int ai = 0; ai < 2; ++ai)
#pragma unroll
                    for (int m = 0; m < 4; ++m)
#pragma unroll
                        for (int bj = 0; bj < 2; ++bj)
                            store8(base + (size_t)(row0 + ai * 128 + m * 16) * 2048 + col0 + bj * 128, acc[ai][bj][m][0], acc[ai][bj][m][1]);
            }
        } else if (mode == 3) {
            bf16_t* p; int ld, col0; bool gate;
            if (u.pn < 4) { p = (bf16_t*)(ws + WS_YA); ld = 1024; col0 = u.pn * 256 + cin; gate = true; }
            else if (u.pn < 12) { p = SCR; ld = 2048; col0 = (u.pn - 4) * 256 + cin; gate = true; }
            else { const int s = (u.pn - 12) >> 2; p = SCR + (size_t)(2 + s) * SLOT_ELEMS; ld = 1024; col0 = ((u.pn - 12) & 3) * 256 + cin; gate = false; }
#pragma unroll
            for (int ai = 0; ai < 2; ++ai)
#pragma unroll
                for (int m = 0; m < 4; ++m)
#pragma unroll
                    for (int bj = 0; bj < 2; ++bj) {
                        bf16_t* q = p + (size_t)(row0 + ai * 128 + m * 16) * ld + col0 + bj * 128;
                        f32x4 v0 = acc[ai][bj][m][0], v1 = acc[ai][bj][m][1];
                        if (gate) {
                            const u32x4 y = *(const u32x4*)q;
                            v0[0] = siluf_(v0[0]) * bflo(y.x); v0[1] = siluf_(v0[1]) * bfhi(y.x); v0[2] = siluf_(v0[2]) * bflo(y.y); v0[3] = siluf_(v0[3]) * bfhi(y.y);
                            v1[0] = siluf_(v1[0]) * bflo(y.z); v1[1] = siluf_(v1[1]) * bfhi(y.z); v1[2] = siluf_(v1[2]) * bflo(y.w); v1[3] = siluf_(v1[3]) * bfhi(y.w);
                        } else {
#pragma unroll
                            for (int j = 0; j < 4; ++j) { v0[j] = sigmoidf_(v0[j]); v1[j] = sigmoidf_(v1[j]); }
                        }
                        store8(q, v0, v1);
                        asm volatile("" ::: "memory");
                    }
        } else if (mode == 4 || mode == 5) {
            const bf16_t* sg = SCR + (size_t)(mode == 4 ? 2 : 3) * SLOT_ELEMS;
            bf16_t* mg = (bf16_t*)(ws + WS_HX);
            const int col0 = u.pn * 256 + cin;
#pragma unroll
            for (int ai = 0; ai < 2; ++ai)
#pragma unroll
                for (int m = 0; m < 4; ++m)
#pragma unroll
                    for (int bj = 0; bj < 2; ++bj) {
                        const size_t off = (size_t)(row0 + ai * 128 + m * 16) * 1024 + col0 + bj * 128;
                        const u32x4 g = *(const u32x4*)(sg + off);
                        f32x4 v0 = acc[ai][bj][m][0], v1 = acc[ai][bj][m][1];
                        v0[0] *= bflo(g.x); v0[1] *= bfhi(g.x); v0[2] *= bflo(g.y); v0[3] *= bfhi(g.y);
                        v1[0] *= bflo(g.z); v1[1] *= bfhi(g.z); v1[2] *= bflo(g.w); v1[3] *= bfhi(g.w);
                        if (mode == 4) { *(f32x4*)(out + off) = v0; *(f32x4*)(out + off + 4) = v1; }
                        else { v0 += *(const f32x4*)(out + off); v1 += *(const f32x4*)(out + off + 4); store8(mg + off, v0, v1); }
                        asm volatile("" ::: "memory");
                    }
        } else if (mode == 6 || mode == 8) {
            const int col0 = u.pn * 256 + cin;
            const float* res = mode == 6 ? x : out;
            const float* gv = (const float*)(ws + WS_MODF) + (size_t)(u.pm >= 32 ? 1 : 0) * 6144 + (mode == 6 ? 2048 : 5120);
#pragma unroll
            for (int bj = 0; bj < 2; ++bj) {
                const f32x4 g0 = *(const f32x4*)(gv + col0 + bj * 128), g1 = *(const f32x4*)(gv + col0 + bj * 128 + 4);
#pragma unroll
                for (int ai = 0; ai < 2; ++ai)
#pragma unroll
                    for (int m = 0; m < 4; ++m) {
                        const size_t off = (size_t)(row0 + ai * 128 + m * 16) * 1024 + col0 + bj * 128;
                        const f32x4 r0 = *(const f32x4*)(res + off), r1 = *(const f32x4*)(res + off + 4);
                        *(f32x4*)(out + off) = r0 + g0 * acc[ai][bj][m][0];
                        *(f32x4*)(out + off + 4) = r1 + g1 * acc[ai][bj][m][1];
                        asm volatile("" ::: "memory");
                    }
            }
        } else {
            const int col0 = u.pn * 128 + cin;
#pragma unroll
            for (int ai = 0; ai < 2; ++ai)
#pragma unroll
                for (int m = 0; m < 4; ++m) {
                    f32x4 v0, v1;
#pragma unroll
                    for (int j = 0; j < 4; ++j) { v0[j] = siluf_(acc[ai][0][m][0][j]) * acc[ai][1][m][0][j]; v1[j] = siluf_(acc[ai][0][m][1][j]) * acc[ai][1][m][1][j]; }
                    store8(SCR + (size_t)(row0 + ai * 128 + m * 16) * DFF + col0, v0, v1);
                }
        }
    }
};

__device__ __forceinline__ void p0_transpose_item(const float* W, int K, int N, bf16_t* WT, int drow0, int k0, int n0, LAS float* scr, int lane) {
#pragma unroll 8
    for (int i = 0; i < 32; ++i) { const int kk = 2 * i + (lane >> 5); scr[kk * 33 + (lane & 31)] = W[(size_t)(k0 + kk) * N + n0 + (lane & 31)]; }
    LDS_WAIT(); asm volatile("" ::: "memory");
    const int c = lane & 7;
#pragma unroll
    for (int j = 0; j < 4; ++j) { const int n = (lane >> 3) + 8 * j; const LAS float* s = scr + (8 * c) * 33 + n;
        u32x4 o; o.x = pkbf(s[0 * 33], s[1 * 33]); o.y = pkbf(s[2 * 33], s[3 * 33]); o.z = pkbf(s[4 * 33], s[5 * 33]); o.w = pkbf(s[6 * 33], s[7 * 33]);
        *(u32x4*)(WT + (size_t)(drow0 + n) * K + k0 + 8 * c) = o; }
    LDS_WAIT(); asm volatile("" ::: "memory");
}
__device__ __forceinline__ int win_map(int c) {
    if (c < 4096) return c;
    if (c < 5120) return 8192 + (c - 4096);
    if (c < 7168) { const int seg = (c - 5120) >> 10, cc = (c - 5120) & 1023, head = cc >> 7, half = (cc >> 6) & 1, e = cc & 63;
        return 4096 + seg * 1024 + 256 * (head >> 1) + 128 * half + 64 * (head & 1) + e; }
    if (c < 9216) return c - 1024;
    return c;
}
__device__ __forceinline__ void p0_phase(const Params& P, LAS unsigned char* lds) {
    int tid_l = threadIdx.x; asm volatile("" : "+v"(tid_l)); const int tid = tid_l, lane = tid & 63, wave = tid >> 6, G = gridDim.x;
    unsigned char* ws = P.ws;
    LAS float* scr = (LAS float*)(lds + wave * 16384);
    const int gw = blockIdx.x * NWAVES + wave, NGW = G * NWAVES;
    constexpr int I0 = 16 * 416, I1 = 16 * 32, I2 = 32 * 32, I3 = 16 * 32, I4 = 16 * 88, I5 = 16 * 88, I6 = 44 * 32;
    constexpr int NITEMS = I0 + I1 + I2 + I3;
    for (int it = gw; it < NITEMS; it += NGW) {
        int r = it;
        if (r < I0) { const int kb = r / 416, nb = r % 416; const int dr = win_map(nb * 32);
            p0_transpose_item(P.in[8], 1024, 13312, dr < 8192 ? (bf16_t*)(ws + WS_W_R12) : (bf16_t*)(ws + WS_W_R3), dr < 8192 ? dr : dr - 8192, kb * 64, nb * 32, scr, lane); continue; } r -= I0;
        if (r < I1) { const int kb = r / 32, nb = r % 32; p0_transpose_item(P.in[14], 1024, 1024, (bf16_t*)(ws + WS_W_PA), nb * 32, kb * 64, nb * 32, scr, lane); continue; } r -= I1;
        if (r < I2) { const int kb = r / 32, nb = r % 32; p0_transpose_item(P.in[15], 2048, 1024, (bf16_t*)(ws + WS_W_PB), nb * 32, kb * 64, nb * 32, scr, lane); continue; } r -= I2;
        { const int kb = r / 32, nb = r % 32; p0_transpose_item(P.in[16], 1024, 1024, (bf16_t*)(ws + WS_W_OUT), nb * 32, kb * 64, nb * 32, scr, lane); }
    }
    __syncthreads();
    LAS float* sv = (LAS float*)lds;
    float* modp = (float*)(ws + WS_MODP);
    for (int item = blockIdx.x; item < 96; item += G) {
        const int ks = item / 12, cb = item % 12, col = cb * 512 + tid;
        if (tid < 384) { const int r = tid >> 7, kk = tid & 127; const float cv = r < 2 ? P.in[1][r * 1024 + ks * 128 + kk] : P.in[3][ks * 128 + kk]; sv[tid] = cv / (1.0f + expf(-cv)); }
        __syncthreads();
        float a0 = 0.f, a1 = 0.f, a2 = 0.f;
        const float* wp = P.in[4] + (size_t)(ks * 128) * 6144 + col;
#pragma unroll 8
        for (int kk = 0; kk < 128; ++kk) { const float w = wp[(size_t)kk * 6144]; a0 += sv[kk] * w; a1 += sv[128 + kk] * w; a2 += sv[256 + kk] * w; }
        modp[(size_t)(ks * 3 + 0) * 6144 + col] = a0; modp[(size_t)(ks * 3 + 1) * 6144 + col] = a1; modp[(size_t)(ks * 3 + 2) * 6144 + col] = a2;
        __syncthreads();
    }
    const int gt = blockIdx.x * NTHREADS + tid, NGT = G * NTHREADS;
    float* lbv = (float*)(ws + WS_LBV); float* rp = (float*)(ws + WS_ROPE);
    for (int i = gt; i < 2048; i += NGT) { const float* s = i < 1024 ? P.in[9] : P.in[10]; const int k = i & 1023; const float a0 = s[k], a1 = s[1024 + k]; lbv[i] = 1.0f / (1.0f + expf(a1 - a0)); }
    for (int i = gt; i < 4096 + 2048; i += NGT) {
        const bool isrow = i < 4096; const int ii = isrow ? i : i - 4096; const int p = ii >> 5, f = ii & 31;
        const float fr = powf(10000.0f, -(float)f / 32.0f); const float ang = (float)p * fr; float sn, cs; sincosf(ang, &sn, &cs);
        if (isrow) { rp[ii] = cs; rp[4096 + ii] = sn; } else { rp[8192 + ii] = cs; rp[8192 + 2048 + ii] = sn; }
    }
}

__device__ __forceinline__ void p0b_phase(const Params& P, LAS unsigned char* lds) {
    int tid_l = threadIdx.x; asm volatile("" : "+v"(tid_l)); const int tid = tid_l, lane = tid & 63, wave = tid >> 6, G = gridDim.x;
    unsigned char* ws = P.ws;
    LAS float* scr = (LAS float*)(lds + wave * 16384);
    const int gw = blockIdx.x * NWAVES + wave, NGW = G * NWAVES;
    constexpr int I4 = 16 * 88, I5 = 16 * 88, I6 = 44 * 32;
    for (int it = gw; it < I4 + I5 + I6; it += NGW) {
        int r = it;
        if (r < I4) { const int kb = r / 88, nb = r % 88, c = nb * 32; p0_transpose_item(P.in[17], 1024, DFF, (bf16_t*)(ws + WS_W_GU), 256 * (c >> 7) + (c & 127), kb * 64, c, scr, lane); continue; } r -= I4;
        if (r < I5) { const int kb = r / 88, nb = r % 88, c = nb * 32; p0_transpose_item(P.in[18], 1024, DFF, (bf16_t*)(ws + WS_W_GU), 256 * (c >> 7) + 128 + (c & 127), kb * 64, c, scr, lane); continue; } r -= I5;
        { const int kb = r / 32, nb = r % 32; p0_transpose_item(P.in[19], DFF, 1024, (bf16_t*)(ws + WS_W_DN), nb * 32, kb * 64, nb * 32, scr, lane); }
    }
}

__device__ __forceinline__ void norm_mod_phase(const float* src0, const float* src1, int nrows, bf16_t* dst, const float* w,
                                               const float* modsrc, int nparts, const float* bias, int sh_off, int sc_off, LAS unsigned char* lds) {
    int tid_l = threadIdx.x; asm volatile("" : "+v"(tid_l)); const int tid = tid_l, lane = tid & 63, wave = tid >> 6, G = gridDim.x;
    LAS float* CA = (LAS float*)lds;
    LAS float* CB = CA + 3072;
    for (int idx = tid; idx < 3072; idx += NTHREADS) {
        const int r = idx >> 10, k = idx & 1023;
        float sh = bias ? bias[sh_off + k] : 0.f, sc = bias ? bias[sc_off + k] : 0.f;
        for (int p = 0; p < nparts; ++p) { sh += modsrc[(size_t)(p * 3 + r) * 6144 + sh_off + k]; sc += modsrc[(size_t)(p * 3 + r) * 6144 + sc_off + k]; }
        CA[idx] = w[k] * (1.0f + sc); CB[idx] = sh;
    }
    __syncthreads();
    for (int row = blockIdx.x * NWAVES + wave; row < nrows; row += G * NWAVES) {
        const float* xr = row < MX ? src0 + (size_t)row * 1024 : src1 + (size_t)(row - MX) * 1024;
        const int r = row < MX ? (row >= SEQ ? 1 : 0) : 2;
        f32x4 v[4]; float s = 0.f;
#pragma unroll
        for (int j = 0; j < 4; ++j) { v[j] = *(const f32x4*)(xr + 4 * lane + 256 * j); s += (v[j][0] * v[j][0] + v[j][1] * v[j][1]) + (v[j][2] * v[j][2] + v[j][3] * v[j][3]); }
        const float rstd = rsqrtf(wave_sum(s) * (1.0f / 1024.0f) + 1e-6f);
#pragma unroll
        for (int j = 0; j < 4; ++j) {
            const f32x4 a = *(const LAS f32x4*)(CA + r * 1024 + 4 * lane + 256 * j), b = *(const LAS f32x4*)(CB + r * 1024 + 4 * lane + 256 * j);
            const f32x4 y = v[j] * rstd * a + b;
            u32x2 o; o.x = pkbf(y[0], y[1]); o.y = pkbf(y[2], y[3]);
            *(u32x2*)(dst + (size_t)row * 1024 + 4 * lane + 256 * j) = o;
        }
    }
}
__device__ __forceinline__ void final_norm_phase(float* io, const float* w) {
    int tid_l = threadIdx.x; asm volatile("" : "+v"(tid_l)); const int tid = tid_l, lane = tid & 63, wave = tid >> 6, G = gridDim.x;
    for (int row = blockIdx.x * NWAVES + wave; row < MX; row += G * NWAVES) {
        float* xr = io + (size_t)row * 1024;
        f32x4 v[4]; float s = 0.f;
#pragma unroll
        for (int j = 0; j < 4; ++j) { v[j] = *(const f32x4*)(xr + 4 * lane + 256 * j); s += (v[j][0] * v[j][0] + v[j][1] * v[j][1]) + (v[j][2] * v[j][2] + v[j][3] * v[j][3]); }
        const float rstd = rsqrtf(wave_sum(s) * (1.0f / 1024.0f) + 1e-6f);
#pragma unroll
        for (int j = 0; j < 4; ++j) { const f32x4 a = *(const f32x4*)(w + 4 * lane + 256 * j); *(f32x4*)(xr + 4 * lane + 256 * j) = v[j] * rstd * a; }
    }
}
__device__ __forceinline__ void norm_h_phase(const float* oh, const float* nw, bf16_t* ya) {
    int tid_l = threadIdx.x; asm volatile("" : "+v"(tid_l)); const int tid = tid_l, lane = tid & 63, wave = tid >> 6, G = gridDim.x;
    for (int row = blockIdx.x * NWAVES + wave; row < MX; row += G * NWAVES) {
        const float* xr = oh + (size_t)row * 1024 + 16 * lane;
        f32x4 v[4]; float s = 0.f;
#pragma unroll
        for (int j = 0; j < 4; ++j) { v[j] = *(const f32x4*)(xr + 4 * j); s += (v[j][0] * v[j][0] + v[j][1] * v[j][1]) + (v[j][2] * v[j][2] + v[j][3] * v[j][3]); }
        s += __shfl_xor(s, 1); s += __shfl_xor(s, 2); s += __shfl_xor(s, 4);
        const float rstd = rsqrtf(s * (1.0f / 128.0f) + 1e-6f);
        u32x4 o[2];
#pragma unroll
        for (int j = 0; j < 4; ++j) { const f32x4 a = *(const f32x4*)(nw + 16 * lane + 4 * j); const f32x4 y = v[j] * rstd * a;
            o[j >> 1][(j & 1) * 2] = pkbf(y[0], y[1]); o[j >> 1][(j & 1) * 2 + 1] = pkbf(y[2], y[3]); }
        *(u32x4*)(ya + (size_t)row * 1024 + 16 * lane) = o[0]; *(u32x4*)(ya + (size_t)row * 1024 + 16 * lane + 8) = o[1];
    }
}
__device__ __forceinline__ void norm_r_phase(const bf16_t* orr, bf16_t* yb) {
    int tid_l = threadIdx.x; asm volatile("" : "+v"(tid_l)); const int tid = tid_l, lane = tid & 63, wave = tid >> 6, G = gridDim.x;
    for (int row = blockIdx.x * NWAVES + wave; row < MX; row += G * NWAVES) {
        const bf16_t* xr = orr + (size_t)row * 2048 + 32 * lane;
        float v[32]; float s = 0.f;
#pragma unroll
        for (int j = 0; j < 4; ++j) { const u32x4 q = *(const u32x4*)(xr + 8 * j);
#pragma unroll
            for (int e = 0; e < 4; ++e) { v[8 * j + 2 * e] = bflo(q[e]); v[8 * j + 2 * e + 1] = bfhi(q[e]); } }
#pragma unroll
        for (int e = 0; e < 32; ++e) s += v[e];
        s += __shfl_xor(s, 1); s += __shfl_xor(s, 2); s += __shfl_xor(s, 4);
        const float mu = s * (1.0f / 256.0f); float q2 = 0.f;
#pragma unroll
        for (int e = 0; e < 32; ++e) { v[e] -= mu; q2 += v[e] * v[e]; }
        q2 += __shfl_xor(q2, 1); q2 += __shfl_xor(q2, 2); q2 += __shfl_xor(q2, 4);
        const float rstd = rsqrtf(q2 * (1.0f / 256.0f) + 1e-5f);
#pragma unroll
        for (int j = 0; j < 4; ++j) { u32x4 o;
#pragma unroll
            for (int e = 0; e < 4; ++e) o[e] = pkbf(v[8 * j + 2 * e] * rstd, v[8 * j + 2 * e + 1] * rstd);
            *(u32x4*)(yb + (size_t)row * 2048 + 32 * lane + 8 * j) = o; }
    }
}

#define MFMA32(a, b, c) __builtin_amdgcn_mfma_f32_32x32x16_bf16((a), (b), (c), 0, 0, 0)
__device__ __forceinline__ int crow(int reg, int h) { return (reg & 3) + 8 * (reg >> 2) + 4 * h; }
__device__ __forceinline__ bf16x8 pack_step(const f32x16& x, int s) {
    u32x4 p; p.x = pkbf(x[8 * s], x[8 * s + 1]); p.y = pkbf(x[8 * s + 2], x[8 * s + 3]); p.z = pkbf(x[8 * s + 4], x[8 * s + 5]); p.w = pkbf(x[8 * s + 6], x[8 * s + 7]);
    return __builtin_bit_cast(bf16x8, p);
}
constexpr int SB_QT = 0, SB_KT = 8704, SB_KTT = 17408, SB_V = 27648, SB_G = 36352, SB_BYTES = 36864;
constexpr int QS = 136, TS = 40;
constexpr int NSEG_H = 16, NSEG_R = 8;

struct ScanItem {
    const bf16_t* q;
    const unsigned short *kl0, *kl1;
    const bf16_t* v; int ldv;
    float lg0, lg1;
    int row_base, nchunk;
    const float *ctx0, *ctx1;
    const float *us0, *us1;
    const float *gs0, *gs1;
    float segdec0, segdec1;
    int m, nseg;
    float *so0, *so1;
    float *go0, *go1;
    float* of32; bf16_t* obf; int ldo;
};

template <int KIND, int PASS>
__device__ __forceinline__ void scan_item(LAS unsigned char* lds, const ScanItem& a) {
    int tid_l = threadIdx.x; asm volatile("" : "+v"(tid_l)); const int tid = tid_l, dir = __builtin_amdgcn_readfirstlane(tid >> 8), t = tid & 255, w4 = __builtin_amdgcn_readfirstlane(t >> 6), lane = t & 63, r = lane & 31, hh = lane >> 5;
    const int n = a.nchunk, d = 32 * w4 + r;
    const unsigned short* klp = dir ? a.kl1 : a.kl0;
    const float lg = dir ? a.lg1 : a.lg0;
    f32x16 S[4];
    if (PASS == 1) {
        const float* cx = dir ? a.ctx1 : a.ctx0;
#pragma unroll
        for (int g = 0; g < 4; ++g)
#pragma unroll
            for (int i = 0; i < 16; ++i) S[g][i] = cx[(32 * g + crow(i, hh)) * 128 + 32 * w4 + r];
        const float* us = dir ? a.us1 : a.us0; const float* gs = dir ? a.gs1 : a.gs0; const float sdec = __expf(dir ? a.segdec1 : a.segdec0);
        const int cnt = dir ? a.nseg - 1 - a.m : a.m;
        for (int q = 0; q < cnt; ++q) {
            const int mm = dir ? a.nseg - 1 - q : q;
            const float* U = us + (size_t)mm * 16384;
#pragma unroll
            for (int g = 0; g < 4; ++g)
#pragma unroll
                for (int i = 0; i < 16; ++i) {
                    const int dd = 32 * g + crow(i, hh);
                    const float dec = KIND == 0 ? __expf(gs[mm * 128 + dd]) : sdec;
                    S[g][i] = S[g][i] * dec + U[dd * 128 + 32 * w4 + r];
                }
        }
    } else {
#pragma unroll
        for (int g = 0; g < 4; ++g)
#pragma unroll
            for (int i = 0; i < 16; ++i) S[g][i] = 0.f;
    }
    float gtot = 0.f;
    unsigned short rq[16], rk[16]; u32x4 rv0, rv1;
    const int vs = t >> 3, vq = t & 7;
#define LOAD_RAW(jn) do { \
        const int c_ = dir ? n - 1 - (jn) : (jn); \
        const size_t rb_ = (size_t)a.row_base + 32 * c_; \
        _Pragma("unroll") for (int ii = 0; ii < 16; ++ii) { \
            const int i_ = 16 * hh + ii; const size_t row_ = rb_ + (dir ? 31 - i_ : i_); \
            if (PASS == 1) rq[ii] = a.q[row_ * 1024 + d]; \
            rk[ii] = klp[row_ * 1024 + d]; \
        } \
        { const size_t row_ = rb_ + (dir ? 31 - vs : vs); rv0 = *(const u32x4*)(a.v + row_ * a.ldv + 16 * vq); rv1 = *(const u32x4*)(a.v + row_ * a.ldv + 16 * vq + 8); } \
    } while (0)
    LOAD_RAW(0);
    for (int j = 0; j < n; ++j) {
        LAS unsigned char* L = lds + (dir * 2 + (j & 1)) * SB_BYTES;
        LAS bf16_t* QT = (LAS bf16_t*)(L + SB_QT); LAS bf16_t* KT = (LAS bf16_t*)(L + SB_KT);
        LAS bf16_t* KTT = (LAS bf16_t*)(L + SB_KTT); LAS bf16_t* VR = (LAS bf16_t*)(L + SB_V);
        LAS float* GV = (LAS float*)(L + SB_G);
        {
            float b[16], kk[16];
            if (KIND == 0) {
                float run = 0.f;
#pragma unroll
                for (int ii = 0; ii < 16; ++ii) { const float lf = f16tof(rk[ii]); run += lf; b[ii] = run; kk[ii] = 1.0f - __expf(lf); }
                const float other = __shfl_xor(run, 32);
                const float off = hh ? other : 0.f;
#pragma unroll
                for (int ii = 0; ii < 16; ++ii) b[ii] += off;
                if (hh == 0) GV[d] = __expf(run + other);
                gtot += run + other;
            } else {
#pragma unroll
                for (int ii = 0; ii < 16; ++ii) { b[ii] = (float)(16 * hh + ii + 1) * lg; kk[ii] = bf2f(rk[ii]); }
                if (hh == 0) GV[d] = __expf(32.0f * lg);
            }
            unsigned kt[8];
#pragma unroll
            for (int ii = 0; ii < 16; ii += 2) {
                const float e0 = __expf(b[ii]), e1 = __expf(b[ii + 1]);
                const unsigned kq = pkbf(kk[ii] * __builtin_amdgcn_rcpf(e0), kk[ii + 1] * __builtin_amdgcn_rcpf(e1));
                kt[ii >> 1] = kq;
                const int i = 16 * hh + ii;
                if (PASS == 1) {
                    const unsigned qq = pkbf(bf2f(rq[ii]) * e0, bf2f(rq[ii + 1]) * e1);
                    QT[i * QS + d] = (bf16_t)(qq & 0xffffu); QT[(i + 1) * QS + d] = (bf16_t)(qq >> 16);
                    KT[i * QS + d] = (bf16_t)(kq & 0xffffu); KT[(i + 1) * QS + d] = (bf16_t)(kq >> 16);
                }
            }
            *(LAS u32x4*)(KTT + d * TS + 16 * hh) = (u32x4){kt[0], kt[1], kt[2], kt[3]};
            *(LAS u32x4*)(KTT + d * TS + 16 * hh + 8) = (u32x4){kt[4], kt[5], kt[6], kt[7]};
            *(LAS u32x4*)(VR + vs * QS + 16 * vq) = rv0; *(LAS u32x4*)(VR + vs * QS + 16 * vq + 8) = rv1;
        }
        if (PASS == 1 && j == (n >> 1)) asm volatile("s_waitcnt vmcnt(0)" ::: "memory");
        __syncthreads();
        if (j + 1 < n) LOAD_RAW(j + 1);
        bf16x8 vb[2];
#pragma unroll
        for (int ks = 0; ks < 2; ++ks) {
            u32x4 p;
#pragma unroll
            for (int jj = 0; jj < 8; jj += 2) {
                const unsigned lo = VR[(16 * ks + 8 * (jj >> 2) + 4 * hh + (jj & 3)) * QS + 32 * w4 + r];
                const unsigned hi = VR[(16 * ks + 8 * (jj >> 2) + 4 * hh + (jj & 3) + 1) * QS + 32 * w4 + r];
                p[jj >> 1] = lo | (hi << 16);
            }
            vb[ks] = __builtin_bit_cast(bf16x8, p);
        }
        if (PASS == 1) {
            f32x16 at;
#pragma unroll
            for (int i = 0; i < 16; ++i) at[i] = 0.f;
#pragma unroll
            for (int ks = 0; ks < 8; ++ks) {
                const bf16x8 ka = *(const LAS bf16x8*)(KT + r * QS + 16 * ks + 8 * hh);
                const bf16x8 qb = *(const LAS bf16x8*)(QT + r * QS + 16 * ks + 8 * hh);
                at = MFMA32(ka, qb, at);
            }
#pragma unroll
            for (int i = 0; i < 16; ++i) if (crow(i, hh) > r) at[i] = 0.f;
            f32x16 o;
#pragma unroll
            for (int i = 0; i < 16; ++i) o[i] = 0.f;
#pragma unroll
            for (int ks = 0; ks < 2; ++ks) o = MFMA32(pack_step(at, ks), vb[ks], o);
#pragma unroll
            for (int g = 0; g < 4; ++g)
#pragma unroll
                for (int ks = 0; ks < 2; ++ks) {
                    const s16x4 qlo = *(const LAS s16x4*)(QT + r * QS + 32 * g + 16 * ks + 4 * hh), qhi = *(const LAS s16x4*)(QT + r * QS + 32 * g + 16 * ks + 8 + 4 * hh);
                    const bf16x8 qa = __builtin_shufflevector(qlo, qhi, 0, 1, 2, 3, 4, 5, 6, 7);
                    o = MFMA32(qa, pack_step(S[g], ks), o);
                }
            const int c = dir ? n - 1 - j : j;
            const bool second = j >= (n >> 1);
            const size_t rb = (size_t)a.row_base + 32 * c;
#pragma unroll
            for (int i = 0; i < 16; ++i) {
                const int tl = crow(i, hh); const size_t row = rb + (dir ? 31 - tl : tl);
                if (KIND == 0) {
                    float* p = a.of32 + row * a.ldo + 32 * w4 + r;
                    float val = o[i]; if (second) val += __builtin_nontemporal_load(p);
                    *p = val;
                } else {
                    bf16_t* p = a.obf + row * a.ldo + 32 * w4 + r;
                    float val = o[i]; if (second) val += bf2f(__builtin_nontemporal_load(p));
                    *p = (bf16_t)(pkbf(val, 0.f) & 0xffffu);
                }
            }
        }
#pragma unroll
        for (int g = 0; g < 4; ++g) {
#pragma unroll
            for (int ks = 0; ks < 2; ++ks) {
                const s16x4 klo = *(const LAS s16x4*)(KTT + (32 * g + r) * TS + 16 * ks + 4 * hh), khi = *(const LAS s16x4*)(KTT + (32 * g + r) * TS + 16 * ks + 8 + 4 * hh);
                const bf16x8 ka = __builtin_shufflevector(klo, khi, 0, 1, 2, 3, 4, 5, 6, 7);
                S[g] = MFMA32(ka, vb[ks], S[g]);
            }
#pragma unroll
            for (int q4 = 0; q4 < 4; ++q4) { const f32x4 gv = *(const LAS f32x4*)(GV + 32 * g + 8 * q4 + 4 * hh);
#pragma unroll
                for (int jj = 0; jj < 4; ++jj) S[g][4 * q4 + jj] *= gv[jj]; }
        }
    }
#undef LOAD_RAW
    if (PASS == 0) {
        float* so = dir ? a.so1 : a.so0;
#pragma unroll
        for (int g = 0; g < 4; ++g)
#pragma unroll
            for (int i = 0; i < 16; ++i) so[(32 * g + crow(i, hh)) * 128 + 32 * w4 + r] = S[g][i];
        float* go = dir ? a.go1 : a.go0;
        if (KIND == 0 && go && hh == 0) go[d] = gtot;
    }
    __syncthreads();
}

__device__ __forceinline__ float log_sigmoid_(float th) { return -log1pf(expf(-th)); }

template <int KIND, int PASS>
__device__ __forceinline__ void scan_phase(const Params& P, LAS unsigned char* lds) {
    unsigned char* ws = P.ws;
    bf16_t* SCR = (bf16_t*)(ws + WS_SCR);
    constexpr int NSEG = KIND == 0 ? NSEG_H : NSEG_R, NSEQ = KIND == 0 ? 16 : 32, SEGLEN = SEQ / NSEG;
    const int nitems = PASS == 0 ? NSEQ * NSEG + NSEQ : NSEQ * NSEG;
    float* USEG = (float*)(ws + (KIND == 0 ? WS_YA : WS_W_R12));
    float* CS = (float*)(ws + (KIND == 0 ? WS_CSH : WS_CSR));
    float* GS = (float*)(ws + WS_GSUM);
    for (int it = blockIdx.x; it < nitems; it += gridDim.x) {
        const bool isctx = it >= NSEQ * NSEG;
        const int sq = isctx ? it - NSEQ * NSEG : it / NSEG, m = isctx ? 0 : it % NSEG;
        ScanItem a;
        int b, h;
        if (KIND == 0) {
            b = sq >> 3; h = sq & 7;
            a.q = SCR + 128 * h;
            a.kl0 = (const unsigned short*)(SCR + SLOT_ELEMS) + 128 * h; a.kl1 = (const unsigned short*)(SCR + 2 * SLOT_ELEMS) + 128 * h;
            a.v = SCR + 3 * SLOT_ELEMS + 128 * h; a.ldv = 1024; a.lg0 = 0.f; a.lg1 = 0.f; a.segdec0 = 0.f; a.segdec1 = 0.f;
            a.of32 = P.out + 128 * h; a.obf = nullptr; a.ldo = 1024;
        } else {
            const int hv = sq & 1; b = sq >> 4; h = (sq >> 1) & 7;
            a.q = SCR + 128 * h;
            a.kl0 = (const unsigned short*)(SCR + SLOT_ELEMS) + 128 * h; a.kl1 = a.kl0;
            a.v = SCR + 2 * SLOT_ELEMS + 256 * h + 128 * hv; a.ldv = 2048;
            a.lg0 = log_sigmoid_(P.in[12][h]); a.lg1 = log_sigmoid_(P.in[13][h]); a.segdec0 = a.lg0 * (float)SEGLEN; a.segdec1 = a.lg1 * (float)SEGLEN;
            a.of32 = nullptr; a.obf = (bf16_t*)P.out + 256 * h + 128 * hv; a.ldo = 2048;
        }
        a.row_base = isctx ? MX + b * CTXL : b * SEQ + m * SEGLEN; a.nchunk = isctx ? CTXL / 32 : SEGLEN / 32;
        a.ctx0 = CS + (size_t)(sq * 2 + 0) * 16384; a.ctx1 = CS + (size_t)(sq * 2 + 1) * 16384;
        a.us0 = USEG + (size_t)(sq * 2 + 0) * NSEG * 16384; a.us1 = USEG + (size_t)(sq * 2 + 1) * NSEG * 16384;
        a.gs0 = GS + (size_t)(sq * 2 + 0) * NSEG * 128; a.gs1 = GS + (size_t)(sq * 2 + 1) * NSEG * 128;
        a.m = m; a.nseg = NSEG;
        if (isctx) { a.so0 = CS + (size_t)(sq * 2 + 0) * 16384; a.so1 = CS + (size_t)(sq * 2 + 1) * 16384; a.go0 = nullptr; a.go1 = nullptr; }
        else { a.so0 = USEG + ((size_t)(sq * 2 + 0) * NSEG + m) * 16384; a.so1 = USEG + ((size_t)(sq * 2 + 1) * NSEG + m) * 16384;
               a.go0 = GS + ((size_t)(sq * 2 + 0) * NSEG + m) * 128; a.go1 = GS + ((size_t)(sq * 2 + 1) * NSEG + m) * 128; }
        scan_item<KIND, PASS>(lds, a);
    }
}

template <int MODE>
__device__ __forceinline__ void run_gemm(LAS unsigned char* lds, const bf16_t* A, const bf16_t* Bt, int M, int N, int K, const Params& P) {
    pg8::Gemm g{A, Bt, M, N, K}; pg8::StaticOrder S; S.init(M, N, (int)gridDim.x, (int)blockIdx.x);
    EpiAll<MODE> E; E.ws = P.ws; E.x = P.in[0]; E.out = P.out;
    pg8::gemm_phase<EpiAll<MODE>, pg8::StaticOrder, true, true>(lds, g, S, E);
}

__global__ void __launch_bounds__(NTHREADS, 2) mk_fwd(Params P) {
    extern __shared__ __attribute__((aligned(16))) unsigned char lds_raw[];
    LAS unsigned char* lds = (LAS unsigned char*)lds_raw;
    cg::grid_group grid = cg::this_grid();
    unsigned char* ws = P.ws;
    bf16_t* W_R12 = (bf16_t*)(ws + WS_W_R12); bf16_t* HX = (bf16_t*)(ws + WS_HX); bf16_t* YA = (bf16_t*)(ws + WS_YA); bf16_t* SCR = (bf16_t*)(ws + WS_SCR);

    p0_phase(P, lds);
    grid.sync();
    norm_mod_phase(P.in[0], P.in[2], MT, HX, P.in[6], (const float*)(ws + WS_MODP), 8, P.in[5], 0, 1024, lds);
    {
        float* modf_ = (float*)(ws + WS_MODF); const float* modp = (const float*)(ws + WS_MODP);
        const int idx = blockIdx.x * NTHREADS + threadIdx.x;
        for (int i = idx; i < 3 * 6144; i += gridDim.x * NTHREADS) { const int r = i / 6144, jx = i % 6144; float s = P.in[5][jx];
            for (int p = 0; p < 8; ++p) s += modp[(size_t)(p * 3 + r) * 6144 + jx];
            modf_[i] = s; }
    }
    grid.sync();
    run_gemm<1>(lds, HX, W_R12, MT, 4096, 1024, P);
    grid.sync();
    scan_phase<0, 0>(P, lds);
    grid.sync();
    scan_phase<0, 1>(P, lds);
    grid.sync();
    norm_h_phase(P.out, P.in[11], YA);
    grid.sync();
    run_gemm<2>(lds, HX, W_R12 + (size_t)4096 * 1024, MT, 4096, 1024, P);
    grid.sync();
    scan_phase<1, 0>(P, lds);
    grid.sync();
    scan_phase<1, 1>(P, lds);
    grid.sync();
    norm_r_phase((const bf16_t*)P.out, SCR);
    p0b_phase(P, lds);
    grid.sync();
    run_gemm<3>(lds, HX, (const bf16_t*)(ws + WS_W_R3), MX, 5120, 1024, P);
    grid.sync();
    run_gemm<4>(lds, YA, (const bf16_t*)(ws + WS_W_PA), MX, 1024, 1024, P);
    run_gemm<5>(lds, SCR, (const bf16_t*)(ws + WS_W_PB), MX, 1024, 2048, P);
    grid.sync();
    run_gemm<6>(lds, HX, (const bf16_t*)(ws + WS_W_OUT), MX, 1024, 1024, P);
    grid.sync();
    norm_mod_phase(P.out, nullptr, MX, YA, P.in[7], (const float*)(ws + WS_MODF), 1, nullptr, 3072, 4096, lds);
    grid.sync();
    run_gemm<7>(lds, YA, (const bf16_t*)(ws + WS_W_GU), MX, 5632, 1024, P);
    grid.sync();
    run_gemm<8>(lds, SCR, (const bf16_t*)(ws + WS_W_DN), MX, 1024, DFF, P);
    grid.sync();
    final_norm_phase(P.out, P.in[20]);
}

extern "C" void kernel_launch(void* const* d_in, const int* in_sizes, int n_in, void* d_out, int out_size, void* d_ws, size_t ws_size, hipStream_t stream) {
    static int grid_blocks = 0;
    if (grid_blocks == 0) {
        if (n_in != 21 || ws_size < WS_END) { fprintf(stderr, "kernel_launch: unexpected n_in %d / ws_size %zu (need %zu)\n", n_in, ws_size, (size_t)WS_END); grid_blocks = -1; return; }
        int dev = 0, cus = 0, per_cu = 0;
        hipGetDevice(&dev);
        hipDeviceGetAttribute(&cus, hipDeviceAttributeMultiprocessorCount, dev);
        hipFuncSetAttribute((const void*)mk_fwd, hipFuncAttributeMaxDynamicSharedMemorySize, LDS_BYTES);
        hipOccupancyMaxActiveBlocksPerMultiprocessor(&per_cu, (const void*)mk_fwd, NTHREADS, LDS_BYTES);
        if (per_cu < 1) per_cu = 1;
        grid_blocks = cus * per_cu;
        (void)hipGetLastError();
    }
    if (grid_blocks < 0) return;
    Params p{};
    for (int i = 0; i < 21; ++i) p.in[i] = (const float*)d_in[i];
    p.out = (float*)d_out; p.ws = (unsigned char*)d_ws;
    void* args[] = {&p};
    hipError_t e = hipLaunchCooperativeKernel((const void*)mk_fwd, dim3(grid_blocks), dim3(NTHREADS), args, LDS_BYTES, stream);
    if (e != hipSuccess) fprintf(stderr, "cooperative launch failed: %s (grid %d)\n", hipGetErrorString(e), grid_blocks);
}
```

```cpp
#include <hip/hip_runtime.h>
#include <hip/hip_cooperative_groups.h>
#include <cstdio>
#include <cstdint>
namespace cg = cooperative_groups;
namespace pg8 {
#define PG8_LAS __attribute__((address_space(3)))
typedef unsigned short bf16_t;
typedef short bf16x8 __attribute__((ext_vector_type(8)));
typedef float f32x4 __attribute__((ext_vector_type(4)));
typedef unsigned u32x4 __attribute__((ext_vector_type(4)));
constexpr int BM = 256, BK = 64, HALF = 128, HTB = HALF * BK * 2  , STAGE_BYTES = 8 * HTB, NXCD = 8, WGM = 8;

__host__ __device__ __forceinline__ int lds_byte(int r, int c) { const int st = (r >> 4) * 2 + (c >> 5), rr = r & 15, cc = c & 31, ob = rr * 64 + cc * 2; return st * 1024 + (ob ^ (((ob >> 9) & 1) << 5)); }
__host__ __device__ __forceinline__ void stage_rc(int b, int& R, int& C) { const int st = b / 1024, sb = b % 1024, swz = sb ^ (((sb >> 9) & 1) << 5); R = (st >> 1) * 16 + swz / 64; C = (st & 1) * 32 + (swz % 64) / 2; }
__host__ __device__ __forceinline__ int perm32(int rho) { const int n = rho >> 4, i = rho & 15; return 8 * (i >> 2) + 4 * n + (i & 3); }

struct Unit { int pm, pn; };
struct Gemm { const bf16_t* A; const bf16_t* Bt; int M, N, K; };

struct StaticOrder {
    int nM, nN, nwg, G, c;
    __host__ __device__ void init(int M, int N, int G_, int c_) { nM = M / BM; nN = N / BM; nwg = nM * nN; G = G_; c = c_; }
    __host__ __device__ bool next(int i, Unit& u) const {
        const long L = (long)i * G + c; if (L >= nwg) return false;
        int wgid = (int)L; { const int q = nwg / NXCD, r = nwg % NXCD, xcd = wgid % NXCD, off = wgid / NXCD; wgid = (xcd < r ? xcd * (q + 1) : r * (q + 1) + (xcd - r) * q) + off; }
        const int nig = WGM * nN, gid = wgid / nig, fm = gid * WGM, gsz = (nM - fm) < WGM ? (nM - fm) : WGM;
        u.pm = fm + ((wgid % nig) % gsz); u.pn = (wgid % nig) / gsz; return true;
    }
    __device__ __forceinline__ void a_ready(const Unit&) const {}
    __device__ __forceinline__ void done(const Unit&) const {}
};

__device__ __forceinline__ unsigned cvt_pk_bf16(float lo, float hi) { unsigned r; asm volatile("v_cvt_pk_bf16_f32 %0, %1, %2" : "=v"(r) : "v"(lo), "v"(hi)); return r; }
typedef float f32x2 __attribute__((ext_vector_type(2)));
template <class Epi, class Sched, bool ALIGN_EPI = false, bool SP2 = false>
__device__ __forceinline__ void gemm_phase(PG8_LAS unsigned char* lds, const Gemm g, const Sched& S, const Epi& E) {
    int tid_l = threadIdx.x; asm volatile("" : "+v"(tid_l));
    const int tid = tid_l, wid = __builtin_amdgcn_readfirstlane(tid >> 6), lane = tid & 63, wr = wid >> 2, wc = wid & 3, fr = lane & 15, fq = lane >> 4;
    const int K = g.K, nt = K / BK;
    unsigned voffA[2], voffB[2];
#pragma unroll
    for (int i = 0; i < 2; ++i) { int R, C; stage_rc(tid * 16 + i * 8192, R, C); const int Rb = Epi::PERM ? ((R & ~31) + perm32(R & 31)) : R;
        voffA[i] = (unsigned)(R * K + C) * 2u; voffB[i] = (unsigned)(Rb * K + C) * 2u; }
    const size_t kstep = (size_t)(BK * 2);
    const size_t hstep = (size_t)HALF * K * 2;
    const size_t tstep = 2 * hstep;
    const unsigned ldsw = (unsigned)wid * 1024u;
    const int aoff = lds_byte(wr * 64 + fr, fq * 8), boff = lds_byte(wc * 32 + fr, fq * 8);
#define PG8_SA(b, h) (((b) * 2 + (h)) * HTB)
#define PG8_SB(b, h) ((4 + (b) * 2 + (h)) * HTB)
#define PG8_STAGE(bufoff, gbase, voff) do { _Pragma("unroll") for (int _i = 0; _i < 2; ++_i) \
        __builtin_amdgcn_global_load_lds((const unsigned*)((const char*)(gbase) + (voff)[_i]), (PG8_LAS unsigned*)(lds + (bufoff) + ldsw + _i * 8192), 16, 0, 0); } while (0)
#define PG8_LDA(dst, b, h) do { _Pragma("unroll") for (int m = 0; m < 4; ++m) _Pragma("unroll") for (int k = 0; k < 2; ++k) dst[m][k] = *(const PG8_LAS bf16x8*)(lds + PG8_SA(b, h) + aoff + m * 2048 + k * 1024); } while (0)
#define PG8_LDB(dst, b, h) do { _Pragma("unroll") for (int n = 0; n < 2; ++n) _Pragma("unroll") for (int k = 0; k < 2; ++k) dst[n][k] = *(const PG8_LAS bf16x8*)(lds + PG8_SB(b, h) + boff + n * 2048 + k * 1024); } while (0)
#define PG8_MMA(ai, bj, At, Bt) do { __builtin_amdgcn_s_setprio(1); _Pragma("unroll") for (int m = 0; m < 4; ++m) _Pragma("unroll") for (int n = 0; n < 2; ++n) _Pragma("unroll") for (int k = 0; k < 2; ++k) \
        acc[ai][bj][m][n] = __builtin_amdgcn_mfma_f32_16x16x32_bf16(Bt[n][k], At[m][k], acc[ai][bj][m][n], 0, 0, 0); __builtin_amdgcn_s_setprio(0); } while (0)
#define PG8_WAIT_V(n) asm volatile("s_waitcnt vmcnt(" #n ")" ::: "memory")
#define PG8_WAIT_L(n) asm volatile("s_waitcnt lgkmcnt(" #n ")" ::: "memory")
#define PG8_BAR __builtin_amdgcn_s_barrier()
#define PG8_SCHED __builtin_amdgcn_sched_barrier(0)
    Unit cur, nxt; int ui = 0;
    if (!S.next(0, cur)) return;
    f32x4 acc[2][2][4][2];
#pragma unroll
    for (int a = 0; a < 2; ++a)
#pragma unroll
        for (int b = 0; b < 2; ++b)
#pragma unroll
            for (int m = 0; m < 4; ++m)
#pragma unroll
                for (int n = 0; n < 2; ++n) acc[a][b][m][n] = (f32x4){0.f, 0.f, 0.f, 0.f};
    bf16x8 At[4][2], B0[2][2], B1[2][2];
    const char* cA = (const char*)g.A + (size_t)cur.pm * tstep; const char* cB = (const char*)g.Bt + (size_t)cur.pn * tstep;
    S.a_ready(cur);
    if constexpr (SP2) {
        PG8_STAGE(PG8_SB(0, 0), cB, voffB); PG8_STAGE(PG8_SB(0, 1), cB + hstep, voffB); PG8_STAGE(PG8_SA(0, 0), cA, voffA); PG8_STAGE(PG8_SA(0, 1), cA + hstep, voffA);
        if (wr == 1) PG8_BAR;
        PG8_WAIT_V(2); PG8_BAR;
        PG8_STAGE(PG8_SB(1, 0), cB + kstep, voffB); PG8_STAGE(PG8_SA(1, 0), cA + kstep, voffA); PG8_STAGE(PG8_SB(1, 1), cB + hstep + kstep, voffB);
        PG8_WAIT_V(6); PG8_BAR;
    } else {
        PG8_STAGE(PG8_SB(0, 0), cB, voffB); PG8_STAGE(PG8_SA(0, 0), cA, voffA); PG8_STAGE(PG8_SB(0, 1), cB + hstep, voffB); PG8_STAGE(PG8_SA(0, 1), cA + hstep, voffA);
        if (wr == 1) PG8_BAR;
        PG8_WAIT_V(4); PG8_BAR;
        PG8_STAGE(PG8_SB(1, 0), cB + kstep, voffB); PG8_STAGE(PG8_SA(1, 0), cA + kstep, voffA); PG8_STAGE(PG8_SB(1, 1), cB + hstep + kstep, voffB);
        PG8_WAIT_V(6); PG8_BAR;
    }
    for (;;) {
        const bool has_next = S.next(ui + 1, nxt);
        const char* nA = has_next ? (const char*)g.A + (size_t)nxt.pm * tstep : cA; const char* nB = has_next ? (const char*)g.Bt + (size_t)nxt.pn * tstep : cB;
        for (int t = 0; t < nt; t += 2) {
            const bool last = (t == nt - 2);
            const char* a1 = cA + (size_t)(t + 1) * kstep;
            const char* a2 = last ? nA : cA + (size_t)(t + 2) * kstep; const char* b2 = last ? nB : cB + (size_t)(t + 2) * kstep;
            const char* a3 = a2 + kstep; const char* b3 = b2 + kstep;
            if (last && has_next) S.a_ready(nxt);
            if constexpr (SP2) {
            PG8_LDB(B0, 0, 0); PG8_LDB(B1, 0, 1); PG8_SCHED; PG8_LDA(At, 0, 0); PG8_STAGE(PG8_SA(1, 1), a1 + hstep, voffA);
            PG8_WAIT_V(8); PG8_WAIT_L(0); PG8_BAR; PG8_MMA(0, 0, At, B0); PG8_MMA(0, 1, At, B1); PG8_BAR; PG8_SCHED;
            PG8_LDA(At, 0, 1); PG8_STAGE(PG8_SB(0, 0), b2, voffB); PG8_STAGE(PG8_SB(0, 1), b2 + hstep, voffB); PG8_STAGE(PG8_SA(0, 0), a2, voffA);
            PG8_WAIT_V(8); PG8_WAIT_L(0); PG8_BAR; PG8_MMA(1, 0, At, B0); PG8_MMA(1, 1, At, B1); PG8_BAR; PG8_SCHED;
            PG8_LDB(B0, 1, 0); PG8_LDB(B1, 1, 1); PG8_SCHED; PG8_LDA(At, 1, 0); PG8_STAGE(PG8_SA(0, 1), a2 + hstep, voffA);
            PG8_WAIT_V(8); PG8_WAIT_L(0); PG8_BAR; PG8_MMA(0, 0, At, B0); PG8_MMA(0, 1, At, B1); PG8_BAR; PG8_SCHED;
            PG8_LDA(At, 1, 1); PG8_STAGE(PG8_SB(1, 0), b3, voffB); PG8_STAGE(PG8_SB(1, 1), b3 + hstep, voffB); PG8_STAGE(PG8_SA(1, 0), a3, voffA);
            PG8_WAIT_V(8); PG8_WAIT_L(0); PG8_BAR; PG8_MMA(1, 0, At, B0); PG8_MMA(1, 1, At, B1); PG8_BAR; PG8_SCHED;
            } else {
            PG8_LDB(B0, 0, 0); PG8_SCHED; PG8_LDA(At, 0, 0); PG8_STAGE(PG8_SA(1, 1), a1 + hstep, voffA);
            PG8_WAIT_L(8); PG8_BAR; PG8_WAIT_L(0); PG8_MMA(0, 0, At, B0); PG8_BAR; PG8_SCHED;
            PG8_LDB(B1, 0, 1); PG8_STAGE(PG8_SB(0, 0), b2, voffB);
            PG8_BAR; PG8_WAIT_L(0); PG8_MMA(0, 1, At, B1); PG8_BAR;
            PG8_LDA(At, 0, 1); PG8_STAGE(PG8_SA(0, 0), a2, voffA);
            PG8_BAR; PG8_WAIT_L(0); PG8_MMA(1, 0, At, B0); PG8_BAR; PG8_SCHED;
            PG8_STAGE(PG8_SB(0, 1), b2 + hstep, voffB);
            PG8_WAIT_V(6); PG8_BAR; PG8_MMA(1, 1, At, B1); PG8_BAR;
            PG8_LDB(B0, 1, 0); PG8_SCHED; PG8_LDA(At, 1, 0); PG8_STAGE(PG8_SA(0, 1), a2 + hstep, voffA);
            PG8_WAIT_L(8); PG8_BAR; PG8_WAIT_L(0); PG8_MMA(0, 0, At, B0); PG8_BAR; PG8_SCHED;
            PG8_LDB(B1, 1, 1); PG8_STAGE(PG8_SB(1, 0), b3, voffB);
            PG8_BAR; PG8_WAIT_L(0); PG8_MMA(0, 1, At, B1); PG8_BAR;
            PG8_LDA(At, 1, 1); PG8_STAGE(PG8_SA(1, 0), a3, voffA);
            PG8_BAR; PG8_WAIT_L(0); PG8_MMA(1, 0, At, B0); PG8_BAR; PG8_SCHED;
            PG8_STAGE(PG8_SB(1, 1), b3 + hstep, voffB);
            PG8_WAIT_V(6); PG8_BAR; PG8_MMA(1, 1, At, B1); PG8_BAR;
            }
        }
        if constexpr (ALIGN_EPI) { if (wr == 0) PG8_BAR; }
        if constexpr (!Epi::AFTER_DRAIN) { E(acc, cur, wr, wc, fr, fq); S.done(cur); }
        if (!has_next) break;
#pragma unroll
        for (int a = 0; a < 2; ++a)
#pragma unroll
            for (int b = 0; b < 2; ++b)
#pragma unroll
                for (int m = 0; m < 4; ++m)
#pragma unroll
                    for (int n = 0; n < 2; ++n) acc[a][b][m][n] = (f32x4){0.f, 0.f, 0.f, 0.f};
        cur = nxt; cA = nA; cB = nB; ++ui;
        if constexpr (ALIGN_EPI) { if (wr == 1) PG8_BAR; }
    }
    PG8_WAIT_V(0);
    if constexpr (!ALIGN_EPI) { if (wr == 0) PG8_BAR; }
    PG8_BAR;
    if constexpr (Epi::AFTER_DRAIN) { E.fused(acc, cur, wr, wc, fr, fq, lds, wid, lane); S.done(cur); }
#undef PG8_SA
#undef PG8_SB
#undef PG8_STAGE
#undef PG8_LDA
#undef PG8_LDB
#undef PG8_MMA
#undef PG8_WAIT_V
#undef PG8_WAIT_L
#undef PG8_BAR
#undef PG8_SCHED
}
}

#define LAS __attribute__((address_space(3)))
typedef unsigned short bf16_t;
typedef short bf16x8 __attribute__((ext_vector_type(8)));
typedef short s16x4 __attribute__((ext_vector_type(4)));
typedef float f32x4 __attribute__((ext_vector_type(4)));
typedef float f32x2 __attribute__((ext_vector_type(2)));
typedef float f32x16 __attribute__((ext_vector_type(16)));
typedef unsigned u32x4 __attribute__((ext_vector_type(4)));
typedef unsigned u32x2 __attribute__((ext_vector_type(2)));
typedef __bf16 bf16x2_t __attribute__((ext_vector_type(2)));
typedef _Float16 f16x2_t __attribute__((ext_vector_type(2)));

constexpr int DM = 1024, NBATCH = 2, SEQ = 8192, CTXL = 256;
constexpr int MX = NBATCH * SEQ;
constexpr int MC = NBATCH * CTXL;
constexpr int MT = MX + MC;
constexpr int DFF = 2816;
constexpr int NTHREADS = 512, NWAVES = 8;
constexpr int LDS_BYTES = 4 * 36864 + 1024;

constexpr size_t SLOT_ELEMS = (size_t)MT * 1024;
constexpr size_t WS_W_R12 = 0;
constexpr size_t WS_W_GU  = WS_W_R12 + (size_t)8192 * 1024 * 2;
constexpr size_t WS_W_DN  = WS_W_GU  + (size_t)5632 * 1024 * 2;
constexpr size_t WS_W_R3  = WS_W_DN  + (size_t)1024 * 2816 * 2;
constexpr size_t WS_W_PA  = WS_W_R3  + (size_t)5120 * 1024 * 2;
constexpr size_t WS_W_PB  = WS_W_PA  + (size_t)1024 * 1024 * 2;
constexpr size_t WS_W_OUT = WS_W_PB  + (size_t)1024 * 2048 * 2;
constexpr size_t WS_HX    = WS_W_OUT + (size_t)1024 * 1024 * 2;
constexpr size_t WS_YA    = WS_HX    + SLOT_ELEMS * 2;
constexpr size_t WS_SCR   = WS_YA    + (size_t)MX * 1024 * 2;
constexpr size_t WS_MODP  = WS_SCR   + 4 * SLOT_ELEMS * 2;
constexpr size_t WS_MODF  = WS_MODP  + (size_t)8 * 3 * 6144 * 4;
constexpr size_t WS_LBV   = WS_MODF  + (size_t)3 * 6144 * 4;
constexpr size_t WS_ROPE  = WS_LBV   + (size_t)2 * 1024 * 4;
constexpr size_t WS_CSH   = WS_ROPE  + (size_t)(4096 + 4096 + 2048 + 2048) * 4;
constexpr size_t WS_CSR   = WS_CSH   + (size_t)2 * 2 * 8 * 128 * 128 * 4;
constexpr size_t WS_GSUM  = WS_CSR   + (size_t)2 * 2 * 8 * 128 * 256 * 4;
constexpr size_t WS_END   = WS_GSUM  + (size_t)16 * 2 * 16 * 128 * 4;
constexpr size_t WS_BAR   = WS_END + 1024;
static_assert(WS_W_R3 - WS_W_R12 >= (size_t)32 * 2 * 8 * 16384 * 4, "retention segment states must fit");

struct Params { const float* in[21]; float* out; unsigned char* ws; };

__device__ __forceinline__ unsigned pkbf(float lo, float hi) { f32x2 v = {lo, hi}; bf16x2_t b = __builtin_convertvector(v, bf16x2_t); return __builtin_bit_cast(unsigned, b); }
__device__ __forceinline__ unsigned pkf16(float lo, float hi) { f32x2 v = {lo, hi}; f16x2_t b = __builtin_convertvector(v, f16x2_t); return __builtin_bit_cast(unsigned, b); }
__device__ __forceinline__ float bf2f(unsigned short u) { return __builtin_bit_cast(float, (unsigned)u << 16); }
__device__ __forceinline__ float bflo(unsigned u) { return __builtin_bit_cast(float, u << 16); }
__device__ __forceinline__ float bfhi(unsigned u) { return __builtin_bit_cast(float, u & 0xffff0000u); }
__device__ __forceinline__ float f16tof(unsigned short u) { return (float)__builtin_bit_cast(_Float16, u); }
__device__ __forceinline__ float sigmoidf_(float z) { return __builtin_amdgcn_rcpf(1.0f + __expf(-z)); }
__device__ __forceinline__ float siluf_(float z) { return z * sigmoidf_(z); }
__device__ __forceinline__ float wave_sum(float v) {
#pragma unroll
    for (int o = 1; o < 64; o <<= 1) v += __shfl_xor(v, o);
    return v;
}
#define LDS_WAIT() asm volatile("s_waitcnt lgkmcnt(0)" ::: "memory")

template <int mode> struct EpiAll {
    static constexpr bool PERM = true, AFTER_DRAIN = false;
    unsigned char* ws; const float* x; float* out;
    __device__ __forceinline__ void store8(bf16_t* p, const f32x4& a, const f32x4& b) const {
        u32x4 w; w.x = pkbf(a[0], a[1]); w.y = pkbf(a[2], a[3]); w.z = pkbf(b[0], b[1]); w.w = pkbf(b[2], b[3]); *(u32x4*)p = w;
    }
    __device__ __forceinline__ void operator()(const f32x4 (&acc)[2][2][4][2], const pg8::Unit& u, int wr, int wc, int fr, int fq) const {
        const int row0 = u.pm * 256 + wr * 64 + fr;
        const int cin = wc * 32 + 8 * fq;
        bf16_t* SCR = (bf16_t*)(ws + WS_SCR);
        if (mode == 1) {
            const int seg = u.pn >> 2, col0 = (u.pn & 3) * 256 + cin;
            bf16_t* base = SCR + (size_t)seg * SLOT_ELEMS;
            if (seg == 1 || seg == 2) {
                const float* lbv = (const float*)(ws + WS_LBV) + (seg - 1) * 1024;
#pragma unroll
                for (int bj = 0; bj < 2; ++bj) {
                    const f32x4 l0 = *(const f32x4*)(lbv + col0 + bj * 128), l1 = *(const f32x4*)(lbv + col0 + bj * 128 + 4);
#pragma unroll
                    for (int ai = 0; ai < 2; ++ai)
#pragma unroll
                        for (int m = 0; m < 4; ++m) {
                            float v[8];
#pragma unroll
                            for (int j = 0; j < 4; ++j) {
                                const float z0 = acc[ai][bj][m][0][j], z1 = acc[ai][bj][m][1][j];
                                v[j] = __logf(l0[j] + (1.0f - l0[j]) * sigmoidf_(z0));
                                v[4 + j] = __logf(l1[j] + (1.0f - l1[j]) * sigmoidf_(z1));
                            }
                            u32x4 w; w.x = pkf16(v[0], v[1]); w.y = pkf16(v[2], v[3]); w.z = pkf16(v[4], v[5]); w.w = pkf16(v[6], v[7]);
                            *(u32x4*)(base + (size_t)(row0 + ai * 128 + m * 16) * 1024 + col0 + bj * 128) = w;
                        }
                }
            } else {
                const float sc = seg == 0 ? 0.08838834764831845f : 1.0f;
#pragma unroll
                for (int ai = 0; ai < 2; ++ai)
#pragma unroll
                    for (int m = 0; m < 4; ++m)
#pragma unroll
                        for (int bj = 0; bj < 2; ++bj)
                            store8(base + (size_t)(row0 + ai * 128 + m * 16) * 1024 + col0 + bj * 128, acc[ai][bj][m][0] * sc, acc[ai][bj][m][1] * sc);
            }
        } else if (mode == 2) {
            if (u.pn < 8) {
                const int seg = u.pn >> 2, tile = u.pn & 3;
                bf16_t* base = SCR + (size_t)seg * SLOT_ELEMS;
                const float sc = seg == 0 ? 0.08838834764831845f : 1.0f;
                const int head = 2 * tile + (cin >> 6), e = cin & 63;
                const float* rp = (const float*)(ws + WS_ROPE);
                const bool latent = u.pm < 64;
#pragma unroll
                for (int ai = 0; ai < 2; ++ai)
#pragma unroll
                    for (int m = 0; m < 4; ++m) {
                        const int row = row0 + ai * 128 + m * 16;
                        f32x4 c0 = {1.f, 1.f, 1.f, 1.f}, c1 = c0, s0 = {0.f, 0.f, 0.f, 0.f}, s1 = s0;
                        if (latent) {
                            const int pos = row & (SEQ - 1), prow = pos >> 6, pcol = pos & 63;
                            const float* cp = e < 32 ? rp + prow * 32 + e : rp + 8192 + pcol * 32 + (e - 32);
                            const float* sp = e < 32 ? rp + 4096 + prow * 32 + e : rp + 8192 + 2048 + pcol * 32 + (e - 32);
                            c0 = *(const f32x4*)cp; c1 = *(const f32x4*)(cp + 4); s0 = *(const f32x4*)sp; s1 = *(const f32x4*)(sp + 4);
                        }
                        const f32x4 a0 = acc[ai][0][m][0] * sc, a1 = acc[ai][0][m][1] * sc, b0 = acc[ai][1][m][0] * sc, b1 = acc[ai][1][m][1] * sc;
                        bf16_t* p = base + (size_t)row * 1024 + head * 128 + e;
                        store8(p, a0 * c0 - b0 * s0, a1 * c1 - b1 * s1);
                        store8(p + 64, a0 * s0 + b0 * c0, a1 * s1 + b1 * c1);
                        asm volatile("" ::: "memory");
                    }
            } else {
                bf16_t* base = SCR + 2 * SLOT_ELEMS;
                const int col0 = (u.pn - 8) * 256 + cin;
#pragma unroll
                for (int ai = 0; ai < 2; ++ai)
#pragma unroll
                    for (int m = 0; m < 4; ++m)
#pragma unroll
                        for (int bj = 0; bj < 2; ++bj)
                            store8(base + (size_t)(row0 + ai * 128 + m * 16) * 2048 + col0 + bj * 128, acc[ai][bj][m][0], acc[ai][bj][m][1]);
            }
        } else if (mode == 3) {
            bf16_t* p; int ld, col0; bool gate;
            if (u.pn < 4) { p = (bf16_t*)(ws + WS_YA); ld = 1024; col0 = u.pn * 256 + cin; gate = true; }
            else if (u.pn < 12) { p = SCR; ld = 2048; col0 = (u.pn - 4) * 256 + cin; gate = true; }
            else { const int s = (u.pn - 12) >> 2; p = SCR + (size_t)(2 + s) * SLOT_ELEMS; ld = 1024; col0 = ((u.pn - 12) & 3) * 256 + cin; gate = false; }
#pragma unroll
            for (int ai = 0; ai < 2; ++ai)
#pragma unroll
                for (int m = 0; m < 4; ++m)
#pragma unroll
                    for (int bj = 0; bj < 2; ++bj) {
                        bf16_t* q = p + (size_t)(row0 + ai * 128 + m * 16) * ld + col0 + bj * 128;
                        f32x4 v0 = acc[ai][bj][m][0], v1 = acc[ai][bj][m][1];
                        if (gate) {
                            const u32x4 y = *(const u32x4*)q;
                            v0[0] = siluf_(v0[0]) * bflo(y.x); v0[1] = siluf_(v0[1]) * bfhi(y.x); v0[2] = siluf_(v0[2]) * bflo(y.y); v0[3] = siluf_(v0[3]) * bfhi(y.y);
                            v1[0] = siluf_(v1[0]) * bflo(y.z); v1[1] = siluf_(v1[1]) * bfhi(y.z); v1[2] = siluf_(v1[2]) * bflo(y.w); v1[3] = siluf_(v1[3]) * bfhi(y.w);
                        } else {
#pragma unroll
                            for (int j = 0; j < 4; ++j) { v0[j] = sigmoidf_(v0[j]); v1[j] = sigmoidf_(v1[j]); }
                        }
                        store8(q, v0, v1);
                        asm volatile("" ::: "memory");
                    }
        } else if (mode == 4 || mode == 5) {
            const bf16_t* sg = SCR + (size_t)(mode == 4 ? 2 : 3) * SLOT_ELEMS;
            bf16_t* mg = (bf16_t*)(ws + WS_HX);
            const int col0 = u.pn * 256 + cin;
#pragma unroll
            for (int ai = 0; ai < 2; ++ai)
#pragma unroll
                for (int m = 0; m < 4; ++m)
#pragma unroll
                    for (int bj = 0; bj < 2; ++bj) {
                        const size_t off = (size_t)(row0 + ai * 128 + m * 16) * 1024 + col0 + bj * 128;
                        const u32x4 g = *(const u32x4*)(sg + off);
                        f32x4 v0 = acc[ai][bj][m][0], v1 = acc[ai][bj][m][1];
                        v0[0] *= bflo(g.x); v0[1] *= bfhi(g.x); v0[2] *= bflo(g.y); v0[3] *= bfhi(g.y);
                        v1[0] *= bflo(g.z); v1[1] *= bfhi(g.z); v1[2] *= bflo(g.w); v1[3] *= bfhi(g.w);
                        if (mode == 4) { *(f32x4*)(out + off) = v0; *(f32x4*)(out + off + 4) = v1; }
                        else { v0 += *(const f32x4*)(out + off); v1 += *(const f32x4*)(out + off + 4); store8(mg + off, v0, v1); }
                        asm volatile("" ::: "memory");
                    }
        } else if (mode == 6 || mode == 8) {
            const int col0 = u.pn * 256 + cin;
            const float* res = mode == 6 ? x : out;
            const float* gv = (const float*)(ws + WS_MODF) + (size_t)(u.pm >= 32 ? 1 : 0) * 6144 + (mode == 6 ? 2048 : 5120);
#pragma unroll
            for (int bj = 0; bj < 2; ++bj) {
                const f32x4 g0 = *(const f32x4*)(gv + col0 + bj * 128), g1 = *(const f32x4*)(gv + col0 + bj * 128 + 4);
#pragma unroll
                for (int ai = 0; ai < 2; ++ai)
#pragma unroll
                    for (int m = 0; m < 4; ++m) {
                        const size_t off = (size_t)(row0 + ai * 128 + m * 16) * 1024 + col0 + bj * 128;
                        const f32x4 r0 = *(const f32x4*)(res + off), r1 = *(const f32x4*)(res + off + 4);
                        *(f32x4*)(out + off) = r0 + g0 * acc[ai][bj][m][0];
                        *(f32x4*)(out + off + 4) = r1 + g1 * acc[ai][bj][m][1];
                        asm volatile("" ::: "memory");
                    }
            }
        } else {
            const int col0 = u.pn * 128 + cin;
#pragma unroll
            for (int ai = 0; ai < 2; ++ai)
#pragma unroll
                for (int m = 0; m < 4; ++m) {
                    f32x4 v0, v1;
#pragma unroll
                    for (int j = 0; j < 4; ++j) { v0[j] = siluf_(acc[ai][0][m][0][j]) * acc[ai][1][m][0][j]; v1[j] = siluf_(acc[ai][0][m][1][j]) * acc[ai][1][m][1][j]; }
                    store8(SCR + (size_t)(row0 + ai * 128 + m * 16) * DFF + col0, v0, v1);
                }
        }
    }
};

__device__ __forceinline__ void p0_transpose_item(const float* W, int K, int N, bf16_t* WT, int drow0, int k0, int n0, LAS float* scr, int lane) {
#pragma unroll 8
    for (int i = 0; i < 32; ++i) { const int kk = 2 * i + (lane >> 5); scr[kk * 33 + (lane & 31)] = W[(size_t)(k0 + kk) * N + n0 + (lane & 31)]; }
    LDS_WAIT(); asm volatile("" ::: "memory");
    const int c = lane & 7;
#pragma unroll
    for (int j = 0; j < 4; ++j) { const int n = (lane >> 3) + 8 * j; const LAS float* s = scr + (8 * c) * 33 + n;
        u32x4 o; o.x = pkbf(s[0 * 33], s[1 * 33]); o.y = pkbf(s[2 * 33], s[3 * 33]); o.z = pkbf(s[4 * 33], s[5 * 33]); o.w = pkbf(s[6 * 33], s[7 * 33]);
        *(u32x4*)(WT + (size_t)(drow0 + n) * K + k0 + 8 * c) = o; }
    LDS_WAIT(); asm volatile("" ::: "memory");
}
__device__ __forceinline__ int win_map(int c) {
    if (c < 4096) return c;
    if (c < 5120) return 8192 + (c - 4096);
    if (c < 7168) { const int seg = (c - 5120) >> 10, cc = (c - 5120) & 1023, head = cc >> 7, half = (cc >> 6) & 1, e = cc & 63;
        return 4096 + seg * 1024 + 256 * (head >> 1) + 128 * half + 64 * (head & 1) + e; }
    if (c < 9216) return c - 1024;
    return c;
}
__device__ __forceinline__ void p0_phase(const Params& P, LAS unsigned char* lds) {
    int tid_l = threadIdx.x; asm volatile("" : "+v"(tid_l)); const int tid = tid_l, lane = tid & 63, wave = tid >> 6, G = gridDim.x;
    unsigned char* ws = P.ws;
    LAS float* scr = (LAS float*)(lds + wave * 16384);
    const int gw = blockIdx.x * NWAVES + wave, NGW = G * NWAVES;
    constexpr int I0 = 16 * 416, I1 = 16 * 32, I2 = 32 * 32, I3 = 16 * 32, I4 = 16 * 88, I5 = 16 * 88, I6 = 44 * 32;
    constexpr int NITEMS = I0 + I1 + I2 + I3;
    for (int it = gw; it < NITEMS; it += NGW) {
        int r = it;
        if (r < I0) { const int kb = r / 416, nb = r % 416; const int dr = win_map(nb * 32);
            p0_transpose_item(P.in[8], 1024, 13312, dr < 8192 ? (bf16_t*)(ws + WS_W_R12) : (bf16_t*)(ws + WS_W_R3), dr < 8192 ? dr : dr - 8192, kb * 64, nb * 32, scr, lane); continue; } r -= I0;
        if (r < I1) { const int kb = r / 32, nb = r % 32; p0_transpose_item(P.in[14], 1024, 1024, (bf16_t*)(ws + WS_W_PA), nb * 32, kb * 64, nb * 32, scr, lane); continue; } r -= I1;
        if (r < I2) { const int kb = r / 32, nb = r % 32; p0_transpose_item(P.in[15], 2048, 1024, (bf16_t*)(ws + WS_W_PB), nb * 32, kb * 64, nb * 32, scr, lane); continue; } r -= I2;
        { const int kb = r / 32, nb = r % 32; p0_transpose_item(P.in[16], 1024, 1024, (bf16_t*)(ws + WS_W_OUT), nb * 32, kb * 64, nb * 32, scr, lane); }
    }
    __syncthreads();
    LAS float* sv = (LAS float*)lds;
    float* modp = (float*)(ws + WS_MODP);
    for (int item = blockIdx.x; item < 96; item += G) {
        const int ks = item / 12, cb = item % 12, col = cb * 512 + tid;
        if (tid < 384) { const int r = tid >> 7, kk = tid & 127; const float cv = r < 2 ? P.in[1][r * 1024 + ks * 128 + kk] : P.in[3][ks * 128 + kk]; sv[tid] = cv / (1.0f + expf(-cv)); }
        __syncthreads();
        float a0 = 0.f, a1 = 0.f, a2 = 0.f;
        const float* wp = P.in[4] + (size_t)(ks * 128) * 6144 + col;
#pragma unroll 8
        for (int kk = 0; kk < 128; ++kk) { const float w = wp[(size_t)kk * 6144]; a0 += sv[kk] * w; a1 += sv[128 + kk] * w; a2 += sv[256 + kk] * w; }
        modp[(size_t)(ks * 3 + 0) * 6144 + col] = a0; modp[(size_t)(ks * 3 + 1) * 6144 + col] = a1; modp[(size_t)(ks * 3 + 2) * 6144 + col] = a2;
        __syncthreads();
    }
    const int gt = blockIdx.x * NTHREADS + tid, NGT = G * NTHREADS;
    float* lbv = (float*)(ws + WS_LBV); float* rp = (float*)(ws + WS_ROPE);
    for (int i = gt; i < 2048; i += NGT) { const float* s = i < 1024 ? P.in[9] : P.in[10]; const int k = i & 1023; const float a0 = s[k], a1 = s[1024 + k]; lbv[i] = 1.0f / (1.0f + expf(a1 - a0)); }
    for (int i = gt; i < 4096 + 2048; i += NGT) {
        const bool isrow = i < 4096; const int ii = isrow ? i : i - 4096; const int p = ii >> 5, f = ii & 31;
        const float fr = powf(10000.0f, -(float)f / 32.0f); const float ang = (float)p * fr; float sn, cs; sincosf(ang, &sn, &cs);
        if (isrow) { rp[ii] = cs; rp[4096 + ii] = sn; } else { rp[8192 + ii] = cs; rp[8192 + 2048 + ii] = sn; }
    }
}

__device__ __forceinline__ void p0b_phase(const Params& P, LAS unsigned char* lds) {
    int tid_l = threadIdx.x; asm volatile("" : "+v"(tid_l)); const int tid = tid_l, lane = tid & 63, wave = tid >> 6, G = gridDim.x;
    unsigned char* ws = P.ws;
    LAS float* scr = (LAS float*)(lds + wave * 16384);
    const int gw = blockIdx.x * NWAVES + wave, NGW = G * NWAVES;
    constexpr int I4 = 16 * 88, I5 = 16 * 88, I6 = 44 * 32;
    for (int it = gw; it < I4 + I5 + I6; it += NGW) {
        int r = it;
        if (r < I4) { const int kb = r / 88, nb = r % 88, c = nb * 32; p0_transpose_item(P.in[17], 1024, DFF, (bf16_t*)(ws + WS_W_GU), 256 * (c >> 7) + (c & 127), kb * 64, c, scr, lane); continue; } r -= I4;
        if (r < I5) { const int kb = r / 88, nb = r % 88, c = nb * 32; p0_transpose_item(P.in[18], 1024, DFF, (bf16_t*)(ws + WS_W_GU), 256 * (c >> 7) + 128 + (c & 127), kb * 64, c, scr, lane); continue; } r -= I5;
        { const int kb = r / 32, nb = r % 32; p0_transpose_item(P.in[19], DFF, 1024, (bf16_t*)(ws + WS_W_DN), nb * 32, kb * 64, nb * 32, scr, lane); }
    }
}

__device__ __forceinline__ void norm_mod_phase(const float* src0, const float* src1, int nrows, bf16_t* dst, const float* w,
                                               const float* modsrc, int nparts, const float* bias, int sh_off, int sc_off, LAS unsigned char* lds) {
    int tid_l = threadIdx.x; asm volatile("" : "+v"(tid_l)); const int tid = tid_l, lane = tid & 63, wave = tid >> 6, G = gridDim.x;
    LAS float* CA = (LAS float*)lds;
    LAS float* CB = CA + 3072;
    for (int idx = tid; idx < 3072; idx += NTHREADS) {
        const int r = idx >> 10, k = idx & 1023;
        float sh = bias ? bias[sh_off + k] : 0.f, sc = bias ? bias[sc_off + k] : 0.f;
        for (int p = 0; p < nparts; ++p) { sh += modsrc[(size_t)(p * 3 + r) * 6144 + sh_off + k]; sc += modsrc[(size_t)(p * 3 + r) * 6144 + sc_off + k]; }
        CA[idx] = w[k] * (1.0f + sc); CB[idx] = sh;
    }
    __syncthreads();
    for (int row = blockIdx.x * NWAVES + wave; row < nrows; row += G * NWAVES) {
        const float* xr = row < MX ? src0 + (size_t)row * 1024 : src1 + (size_t)(row - MX) * 1024;
        const int r = row < MX ? (row >= SEQ ? 1 : 0) : 2;
        f32x4 v[4]; float s = 0.f;
#pragma unroll
        for (int j = 0; j < 4; ++j) { v[j] = *(const f32x4*)(xr + 4 * lane + 256 * j); s += (v[j][0] * v[j][0] + v[j][1] * v[j][1]) + (v[j][2] * v[j][2] + v[j][3] * v[j][3]); }
        const float rstd = rsqrtf(wave_sum(s) * (1.0f / 1024.0f) + 1e-6f);
#pragma unroll
        for (int j = 0; j < 4; ++j) {
            const f32x4 a = *(const LAS f32x4*)(CA + r * 1024 + 4 * lane + 256 * j), b = *(const LAS f32x4*)(CB + r * 1024 + 4 * lane + 256 * j);
            const f32x4 y = v[j] * rstd * a + b;
            u32x2 o; o.x = pkbf(y[0], y[1]); o.y = pkbf(y[2], y[3]);
            *(u32x2*)(dst + (size_t)row * 1024 + 4 * lane + 256 * j) = o;
        }
    }
}
__device__ __forceinline__ void final_norm_phase(float* io, const float* w) {
    int tid_l = threadIdx.x; asm volatile("" : "+v"(tid_l)); const int tid = tid_l, lane = tid & 63, wave = tid >> 6, G = gridDim.x;
    for (int row = blockIdx.x * NWAVES + wave; row < MX; row += G * NWAVES) {
        float* xr = io + (size_t)row * 1024;
        f32x4 v[4]; float s = 0.f;
#pragma unroll
        for (int j = 0; j < 4; ++j) { v[j] = *(const f32x4*)(xr + 4 * lane + 256 * j); s += (v[j][0] * v[j][0] + v[j][1] * v[j][1]) + (v[j][2] * v[j][2] + v[j][3] * v[j][3]); }
        const float rstd = rsqrtf(wave_sum(s) * (1.0f / 1024.0f) + 1e-6f);
#pragma unroll
        for (int j = 0; j < 4; ++j) { const f32x4 a = *(const f32x4*)(w + 4 * lane + 256 * j); *(f32x4*)(xr + 4 * lane + 256 * j) = v[j] * rstd * a; }
    }
}
__device__ __forceinline__ void norm_h_phase(const float* oh, const float* nw, bf16_t* ya) {
    int tid_l = threadIdx.x; asm volatile("" : "+v"(tid_l)); const int tid = tid_l, lane = tid & 63, wave = tid >> 6, G = gridDim.x;
    for (int row = blockIdx.x * NWAVES + wave; row < MX; row += G * NWAVES) {
        const float* xr = oh + (size_t)row * 1024 + 16 * lane;
        f32x4 v[4]; float s = 0.f;
#pragma unroll
        for (int j = 0; j < 4; ++j) { v[j] = *(const f32x4*)(xr + 4 * j); s += (v[j][0] * v[j][0] + v[j][1] * v[j][1]) + (v[j][2] * v[j][2] + v[j][3] * v[j][3]); }
        s += __shfl_xor(s, 1); s += __shfl_xor(s, 2); s += __shfl_xor(s, 4);
        const float rstd = rsqrtf(s * (1.0f / 128.0f) + 1e-6f);
        u32x4 o[2];
#pragma unroll
        for (int j = 0; j < 4; ++j) { const f32x4 a = *(const f32x4*)(nw + 16 * lane + 4 * j); const f32x4 y = v[j] * rstd * a;
            o[j >> 1][(j & 1) * 2] = pkbf(y[0], y[1]); o[j >> 1][(j & 1) * 2 + 1] = pkbf(y[2], y[3]); }
        *(u32x4*)(ya + (size_t)row * 1024 + 16 * lane) = o[0]; *(u32x4*)(ya + (size_t)row * 1024 + 16 * lane + 8) = o[1];
    }
}
__device__ __forceinline__ void norm_r_phase(const bf16_t* orr, bf16_t* yb) {
    int tid_l = threadIdx.x; asm volatile("" : "+v"(tid_l)); const int tid = tid_l, lane = tid & 63, wave = tid >> 6, G = gridDim.x;
    for (int row = blockIdx.x * NWAVES + wave; row < MX; row += G * NWAVES) {
        const bf16_t* xr = orr + (size_t)row * 2048 + 32 * lane;
        float v[32]; float s = 0.f;
#pragma unroll
        for (int j = 0; j < 4; ++j) { const u32x4 q = *(const u32x4*)(xr + 8 * j);
#pragma unroll
            for (int e = 0; e < 4; ++e) { v[8 * j + 2 * e] = bflo(q[e]); v[8 * j + 2 * e + 1] = bfhi(q[e]); } }
#pragma unroll
        for (int e = 0; e < 32; ++e) s += v[e];
        s += __shfl_xor(s, 1); s += __shfl_xor(s, 2); s += __shfl_xor(s, 4);
        const float mu = s * (1.0f / 256.0f); float q2 = 0.f;
#pragma unroll
        for (int e = 0; e < 32; ++e) { v[e] -= mu; q2 += v[e] * v[e]; }
        q2 += __shfl_xor(q2, 1); q2 += __shfl_xor(q2, 2); q2 += __shfl_xor(q2, 4);
        const float rstd = rsqrtf(q2 * (1.0f / 256.0f) + 1e-5f);
#pragma unroll
        for (int j = 0; j < 4; ++j) { u32x4 o;
#pragma unroll
            for (int e = 0; e < 4; ++e) o[e] = pkbf(v[8 * j + 2 * e] * rstd, v[8 * j + 2 * e + 1] * rstd);
            *(u32x4*)(yb + (size_t)row * 2048 + 32 * lane + 8 * j) = o; }
    }
}

#define MFMA32(a, b, c) __builtin_amdgcn_mfma_f32_32x32x16_bf16((a), (b), (c), 0, 0, 0)
__device__ __forceinline__ int crow(int reg, int h) { return (reg & 3) + 8 * (reg >> 2) + 4 * h; }
__device__ __forceinline__ bf16x8 pack_step(const f32x16& x, int s) {
    u32x4 p; p.x = pkbf(x[8 * s], x[8 * s + 1]); p.y = pkbf(x[8 * s + 2], x[8 * s + 3]); p.z = pkbf(x[8 * s + 4], x[8 * s + 5]); p.w = pkbf(x[8 * s + 6], x[8 * s + 7]);
    return __builtin_bit_cast(bf16x8, p);
}
constexpr int SB_QT = 0, SB_KT = 8704, SB_KTT = 17408, SB_V = 27648, SB_G = 36352, SB_BYTES = 36864;
constexpr int QS = 136, TS = 40;
constexpr int NSEG_H = 16, NSEG_R = 8;

struct ScanItem {
    const bf16_t* q;
    const unsigned short *kl0, *kl1;
    const bf16_t* v; int ldv;
    float lg0, lg1;
    int row_base, nchunk;
    const float *ctx0, *ctx1;
    const float *us0, *us1;
    const float *gs0, *gs1;
    float segdec0, segdec1;
    int m, nseg;
    float *so0, *so1;
    float *go0, *go1;
    float* of32; bf16_t* obf; int ldo;
};

template <int KIND, int PASS>
__device__ __forceinline__ void scan_item(LAS unsigned char* lds, const ScanItem& a) {
    int tid_l = threadIdx.x; asm volatile("" : "+v"(tid_l)); const int tid = tid_l, dir = __builtin_amdgcn_readfirstlane(tid >> 8), t = tid & 255, w4 = __builtin_amdgcn_readfirstlane(t >> 6), lane = t & 63, r = lane & 31, hh = lane >> 5;
    const int n = a.nchunk, d = 32 * w4 + r;
    const unsigned short* klp = dir ? a.kl1 : a.kl0;
    const float lg = dir ? a.lg1 : a.lg0;
    f32x16 S[4];
    if (PASS == 1) {
        const float* cx = dir ? a.ctx1 : a.ctx0;
#pragma unroll
        for (int g = 0; g < 4; ++g)
#pragma unroll
            for (int i = 0; i < 16; ++i) S[g][i] = cx[(32 * g + crow(i, hh)) * 128 + 32 * w4 + r];
        const float* us = dir ? a.us1 : a.us0; const float* gs = dir ? a.gs1 : a.gs0; const float sdec = __expf(dir ? a.segdec1 : a.segdec0);
        const int cnt = dir ? a.nseg - 1 - a.m : a.m;
        for (int q = 0; q < cnt; ++q) {
            const int mm = dir ? a.nseg - 1 - q : q;
            const float* U = us + (size_t)mm * 16384;
#pragma unroll
            for (int g = 0; g < 4; ++g)
#pragma unroll
                for (int i = 0; i < 16; ++i) {
                    const int dd = 32 * g + crow(i, hh);
                    const float dec = KIND == 0 ? __expf(gs[mm * 128 + dd]) : sdec;
                    S[g][i] = S[g][i] * dec + U[dd * 128 + 32 * w4 + r];
                }
        }
    } else {
#pragma unroll
        for (int g = 0; g < 4; ++g)
#pragma unroll
            for (int i = 0; i < 16; ++i) S[g][i] = 0.f;
    }
    float gtot = 0.f;
    unsigned short rq[16], rk[16]; u32x4 rv0, rv1;
    const int vs = t >> 3, vq = t & 7;
#define LOAD_RAW(jn) do { \
        const int c_ = dir ? n - 1 - (jn) : (jn); \
        const size_t rb_ = (size_t)a.row_base + 32 * c_; \
        _Pragma("unroll") for (int ii = 0; ii < 16; ++ii) { \
            const int i_ = 16 * hh + ii; const size_t row_ = rb_ + (dir ? 31 - i_ : i_); \
            if (PASS == 1) rq[ii] = a.q[row_ * 1024 + d]; \
            rk[ii] = klp[row_ * 1024 + d]; \
        } \
        { const size_t row_ = rb_ + (dir ? 31 - vs : vs); rv0 = *(const u32x4*)(a.v + row_ * a.ldv + 16 * vq); rv1 = *(const u32x4*)(a.v + row_ * a.ldv + 16 * vq + 8); } \
    } while (0)
    LOAD_RAW(0);
    for (int j = 0; j < n; ++j) {
        LAS unsigned char* L = lds + (dir * 2 + (j & 1)) * SB_BYTES;
        LAS bf16_t* QT = (LAS bf16_t*)(L + SB_QT); LAS bf16_t* KT = (LAS bf16_t*)(L + SB_KT);
        LAS bf16_t* KTT = (LAS bf16_t*)(L + SB_KTT); LAS bf16_t* VR = (LAS bf16_t*)(L + SB_V);
        LAS float* GV = (LAS float*)(L + SB_G);
        {
            float b[16], kk[16];
            if (KIND == 0) {
                float run = 0.f;
#pragma unroll
                for (int ii = 0; ii < 16; ++ii) { const float lf = f16tof(rk[ii]); run += lf; b[ii] = run; kk[ii] = 1.0f - __expf(lf); }
                const float other = __shfl_xor(run, 32);
                const float off = hh ? other : 0.f;
#pragma unroll
                for (int ii = 0; ii < 16; ++ii) b[ii] += off;
                if (hh == 0) GV[d] = __expf(run + other);
                gtot += run + other;
            } else {
#pragma unroll
                for (int ii = 0; ii < 16; ++ii) { b[ii] = (float)(16 * hh + ii + 1) * lg; kk[ii] = bf2f(rk[ii]); }
                if (hh == 0) GV[d] = __expf(32.0f * lg);
            }
            unsigned kt[8];
#pragma unroll
            for (int ii = 0; ii < 16; ii += 2) {
                const float e0 = __expf(b[ii]), e1 = __expf(b[ii + 1]);
                const unsigned kq = pkbf(kk[ii] * __builtin_amdgcn_rcpf(e0), kk[ii + 1] * __builtin_amdgcn_rcpf(e1));
                kt[ii >> 1] = kq;
                const int i = 16 * hh + ii;
                if (PASS == 1) {
                    const unsigned qq = pkbf(bf2f(rq[ii]) * e0, bf2f(rq[ii + 1]) * e1);
                    QT[i * QS + d] = (bf16_t)(qq & 0xffffu); QT[(i + 1) * QS + d] = (bf16_t)(qq >> 16);
                    KT[i * QS + d] = (bf16_t)(kq & 0xffffu); KT[(i + 1) * QS + d] = (bf16_t)(kq >> 16);
                }
            }
            *(LAS u32x4*)(KTT + d * TS + 16 * hh) = (u32x4){kt[0], kt[1], kt[2], kt[3]};
            *(LAS u32x4*)(KTT + d * TS + 16 * hh + 8) = (u32x4){kt[4], kt[5], kt[6], kt[7]};
            *(LAS u32x4*)(VR + vs * QS + 16 * vq) = rv0; *(LAS u32x4*)(VR + vs * QS + 16 * vq + 8) = rv1;
        }
        if (PASS == 1 && j == (n >> 1)) asm volatile("s_waitcnt vmcnt(0)" ::: "memory");
        __syncthreads();
        if (j + 1 < n) LOAD_RAW(j + 1);
        bf16x8 vb[2];
#pragma unroll
        for (int ks = 0; ks < 2; ++ks) {
            u32x4 p;
#pragma unroll
            for (int jj = 0; jj < 8; jj += 2) {
                const unsigned lo = VR[(16 * ks + 8 * (jj >> 2) + 4 * hh + (jj & 3)) * QS + 32 * w4 + r];
                const unsigned hi = VR[(16 * ks + 8 * (jj >> 2) + 4 * hh + (jj & 3) + 1) * QS + 32 * w4 + r];
                p[jj >> 1] = lo | (hi << 16);
            }
            vb[ks] = __builtin_bit_cast(bf16x8, p);
        }
        if (PASS == 1) {
            f32x16 at;
#pragma unroll
            for (int i = 0; i < 16; ++i) at[i] = 0.f;
#pragma unroll
            for (int ks = 0; ks < 8; ++ks) {
                const bf16x8 ka = *(const LAS bf16x8*)(KT + r * QS + 16 * ks + 8 * hh);
                const bf16x8 qb = *(const LAS bf16x8*)(QT + r * QS + 16 * ks + 8 * hh);
                at = MFMA32(ka, qb, at);
            }
#pragma unroll
            for (int i = 0; i < 16; ++i) if (crow(i, hh) > r) at[i] = 0.f;
            f32x16 o;
#pragma unroll
            for (int i = 0; i < 16; ++i) o[i] = 0.f;
#pragma unroll
            for (int ks = 0; ks < 2; ++ks) o = MFMA32(pack_step(at, ks), vb[ks], o);
#pragma unroll
            for (int g = 0; g < 4; ++g)
#pragma unroll
                for (int ks = 0; ks < 2; ++ks) {
                    const s16x4 qlo = *(const LAS s16x4*)(QT + r * QS + 32 * g + 16 * ks + 4 * hh), qhi = *(const LAS s16x4*)(QT + r * QS + 32 * g + 16 * ks + 8 + 4 * hh);
                    const bf16x8 qa = __builtin_shufflevector(qlo, qhi, 0, 1, 2, 3, 4, 5, 6, 7);
                    o = MFMA32(qa, pack_step(S[g], ks), o);
                }
            const int c = dir ? n - 1 - j : j;
            const bool second = j >= (n >> 1);
            const size_t rb = (size_t)a.row_base + 32 * c;
#pragma unroll
            for (int i = 0; i < 16; ++i) {
                const int tl = crow(i, hh); const size_t row = rb + (dir ? 31 - tl : tl);
                if (KIND == 0) {
                    float* p = a.of32 + row * a.ldo + 32 * w4 + r;
                    float val = o[i]; if (second) val += __builtin_nontemporal_load(p);
                    *p = val;
                } else {
                    bf16_t* p = a.obf + row * a.ldo + 32 * w4 + r;
                    float val = o[i]; if (second) val += bf2f(__builtin_nontemporal_load(p));
                    *p = (bf16_t)(pkbf(val, 0.f) & 0xffffu);
                }
            }
        }
#pragma unroll
        for (int g = 0; g < 4; ++g) {
#pragma unroll
            for (int ks = 0; ks < 2; ++ks) {
                const s16x4 klo = *(const LAS s16x4*)(KTT + (32 * g + r) * TS + 16 * ks + 4 * hh), khi = *(const LAS s16x4*)(KTT + (32 * g + r) * TS + 16 * ks + 8 + 4 * hh);
                const bf16x8 ka = __builtin_shufflevector(klo, khi, 0, 1, 2, 3, 4, 5, 6, 7);
                S[g] = MFMA32(ka, vb[ks], S[g]);
            }
#pragma unroll
            for (int q4 = 0; q4 < 4; ++q4) { const f32x4 gv = *(const LAS f32x4*)(GV + 32 * g + 8 * q4 + 4 * hh);
#pragma unroll
                for (int jj = 0; jj < 4; ++jj) S[g][4 * q4 + jj] *= gv[jj]; }
        }
    }
#undef LOAD_RAW
    if (PASS == 0) {
        float* so = dir ? a.so1 : a.so0;
#pragma unroll
        for (int g = 0; g < 4; ++g)
#pragma unroll
            for (int i = 0; i < 16; ++i) so[(32 * g + crow(i, hh)) * 128 + 32 * w4 + r] = S[g][i];
        float* go = dir ? a.go1 : a.go0;
        if (KIND == 0 && go && hh == 0) go[d] = gtot;
    }
    __syncthreads();
}

__device__ __forceinline__ float log_sigmoid_(float th) { return -log1pf(expf(-th)); }

template <int KIND, int PASS>
__device__ __forceinline__ void scan_phase(const Params& P, LAS unsigned char* lds) {
    unsigned char* ws = P.ws;
    bf16_t* SCR = (bf16_t*)(ws + WS_SCR);
    constexpr int NSEG = KIND == 0 ? NSEG_H : NSEG_R, NSEQ = KIND == 0 ? 16 : 32, SEGLEN = SEQ / NSEG;
    const int nitems = PASS == 0 ? NSEQ * NSEG + NSEQ : NSEQ * NSEG;
    float* USEG = (float*)(ws + (KIND == 0 ? WS_YA : WS_W_R12));
    float* CS = (float*)(ws + (KIND == 0 ? WS_CSH : WS_CSR));
    float* GS = (float*)(ws + WS_GSUM);
    for (int it = blockIdx.x; it < nitems; it += gridDim.x) {
        const bool isctx = it >= NSEQ * NSEG;
        const int sq = isctx ? it - NSEQ * NSEG : it / NSEG, m = isctx ? 0 : it % NSEG;
        ScanItem a;
        int b, h;
        if (KIND == 0) {
            b = sq >> 3; h = sq & 7;
            a.q = SCR + 128 * h;
            a.kl0 = (const unsigned short*)(SCR + SLOT_ELEMS) + 128 * h; a.kl1 = (const unsigned short*)(SCR + 2 * SLOT_ELEMS) + 128 * h;
            a.v = SCR + 3 * SLOT_ELEMS + 128 * h; a.ldv = 1024; a.lg0 = 0.f; a.lg1 = 0.f; a.segdec0 = 0.f; a.segdec1 = 0.f;
            a.of32 = P.out + 128 * h; a.obf = nullptr; a.ldo = 1024;
        } else {
            const int hv = sq & 1; b = sq >> 4; h = (sq >> 1) & 7;
            a.q = SCR + 128 * h;
            a.kl0 = (const unsigned short*)(SCR + SLOT_ELEMS) + 128 * h; a.kl1 = a.kl0;
            a.v = SCR + 2 * SLOT_ELEMS + 256 * h + 128 * hv; a.ldv = 2048;
            a.lg0 = log_sigmoid_(P.in[12][h]); a.lg1 = log_sigmoid_(P.in[13][h]); a.segdec0 = a.lg0 * (float)SEGLEN; a.segdec1 = a.lg1 * (float)SEGLEN;
            a.of32 = nullptr; a.obf = (bf16_t*)P.out + 256 * h + 128 * hv; a.ldo = 2048;
        }
        a.row_base = isctx ? MX + b * CTXL : b * SEQ + m * SEGLEN; a.nchunk = isctx ? CTXL / 32 : SEGLEN / 32;
        a.ctx0 = CS + (size_t)(sq * 2 + 0) * 16384; a.ctx1 = CS + (size_t)(sq * 2 + 1) * 16384;
        a.us0 = USEG + (size_t)(sq * 2 + 0) * NSEG * 16384; a.us1 = USEG + (size_t)(sq * 2 + 1) * NSEG * 16384;
        a.gs0 = GS + (size_t)(sq * 2 + 0) * NSEG * 128; a.gs1 = GS + (size_t)(sq * 2 + 1) * NSEG * 128;
        a.m = m; a.nseg = NSEG;
        if (isctx) { a.so0 = CS + (size_t)(sq * 2 + 0) * 16384; a.so1 = CS + (size_t)(sq * 2 + 1) * 16384; a.go0 = nullptr; a.go1 = nullptr; }
        else { a.so0 = USEG + ((size_t)(sq * 2 + 0) * NSEG + m) * 16384; a.so1 = USEG + ((size_t)(sq * 2 + 1) * NSEG + m) * 16384;
               a.go0 = GS + ((size_t)(sq * 2 + 0) * NSEG + m) * 128; a.go1 = GS + ((size_t)(sq * 2 + 1) * NSEG + m) * 128; }
        scan_item<KIND, PASS>(lds, a);
    }
}

#define XB_TMO      128
#define XB_XCNT(j)  (256  + 64 * (j))
#define XB_XSUB(j)  (1280 + 64 * (j))
#define XB_XGEN(j)  (2304 + 64 * (j))
#define XB_TOP      3328
#define XB_TOPGEN   3392
#define XCD_BAR_WORDS 3456
#define XB_SPIN_CAP (1u << 18)

__device__ __forceinline__ unsigned xb_ld(unsigned* p)              { return __hip_atomic_load(p, __ATOMIC_RELAXED, __HIP_MEMORY_SCOPE_AGENT); }
__device__ __forceinline__ unsigned xb_add(unsigned* p, unsigned v) { return __hip_atomic_fetch_add(p, v, __ATOMIC_RELAXED, __HIP_MEMORY_SCOPE_AGENT); }
__device__ __forceinline__ unsigned xb_xcc_id() { return (unsigned)__builtin_amdgcn_s_getreg((3 << 11) | 20) & 0xFu; }
#define XB_SPIN(cond, bar) do { unsigned _sp = 0; while (cond) { __builtin_amdgcn_s_sleep(1); \
    if ((++_sp & 255u) == 0u) { if (xb_ld(&(bar)[XB_TMO])) break; if (_sp > XB_SPIN_CAP) { atomicAdd(&(bar)[XB_TMO], 1u); break; } } } } while (0)

struct XcdBarrier {
    unsigned* bar; unsigned x;
    volatile LAS unsigned* st;
};

__device__ __forceinline__ XcdBarrier xcd_barrier_post(unsigned* bar, volatile LAS unsigned* st) {
    XcdBarrier b; b.bar = bar; b.x = xb_xcc_id(); b.st = st;
    if (threadIdx.x == 0) (void)xb_add(&bar[XB_XCNT(b.x)], 1u);
    return b;
}
__device__ __forceinline__ void xcd_barrier_complete(unsigned* bar, unsigned x, unsigned& nloc, unsigned& nx) {
    const unsigned G = gridDim.x * gridDim.y * gridDim.z;
    unsigned sum, cnt, mine, sp = 0u;
    for (;;) {
        sum = 0u; cnt = 0u; mine = 0u;
#pragma unroll
        for (unsigned j = 0; j < 16; ++j) { const unsigned c = xb_ld(&bar[XB_XCNT(j)]); sum += c; cnt += (c > 0u) ? 1u : 0u; mine = (j == x) ? c : mine; }
        if (sum == G) break;
        __builtin_amdgcn_s_sleep(1);
        if ((++sp & 255u) == 0u) { if (xb_ld(&bar[XB_TMO])) break; if (sp > XB_SPIN_CAP) { atomicAdd(&bar[XB_TMO], 1u); break; } }
    }
    nloc = mine > 0u ? mine : 1u; nx = cnt > 0u ? cnt : 1u;
}

__device__ __forceinline__ void xcd_barrier(const XcdBarrier& b) {
    asm volatile("s_waitcnt vmcnt(0)" ::: "memory");
    __syncthreads();
    if (threadIdx.x == 0) {
        unsigned* bar = b.bar;
        __builtin_amdgcn_s_waitcnt(0);
        unsigned nloc = b.st[0], nx = b.st[1];
        if (nloc == 0u) { xcd_barrier_complete(bar, b.x, nloc, nx); b.st[0] = nloc; b.st[1] = nx; }
        const unsigned old = xb_add(&bar[XB_XSUB(b.x)], 1u);
        const unsigned gen = old / nloc;
        if (old + 1u == (gen + 1u) * nloc) {
            __builtin_amdgcn_fence(__ATOMIC_RELEASE, "agent");
            asm volatile("s_waitcnt vmcnt(0)" ::: "memory");
            const unsigned og = xb_add(&bar[XB_TOP], 1u);
            const unsigned tg = og / nx;
            if (og + 1u == (tg + 1u) * nx) xb_add(&bar[XB_TOPGEN], 1u);
            else XB_SPIN(xb_ld(&bar[XB_TOPGEN]) == tg, bar);
            __builtin_amdgcn_fence(__ATOMIC_ACQUIRE, "agent");
            xb_add(&bar[XB_XGEN(b.x)], 1u);
            asm volatile("s_waitcnt vmcnt(0)" ::: "memory");
        } else {
            XB_SPIN(xb_ld(&bar[XB_XGEN(b.x)]) == gen, bar);
            __builtin_amdgcn_fence(__ATOMIC_ACQUIRE, "agent");
            asm volatile("s_waitcnt vmcnt(0)" ::: "memory");
        }
    }
    __syncthreads();
}

template <int MODE>
__device__ __forceinline__ void run_gemm(LAS unsigned char* lds, const bf16_t* A, const bf16_t* Bt, int M, int N, int K, const Params& P) {
    pg8::Gemm g{A, Bt, M, N, K}; pg8::StaticOrder S; S.init(M, N, (int)gridDim.x, (int)blockIdx.x);
    EpiAll<MODE> E; E.ws = P.ws; E.x = P.in[0]; E.out = P.out;
    pg8::gemm_phase<EpiAll<MODE>, pg8::StaticOrder, true, true>(lds, g, S, E);
}

#ifndef REP_HA
#define REP_HA 1
#endif
#ifndef REP_HB
#define REP_HB 1
#endif
#ifndef REP_RA
#define REP_RA 1
#endif
#ifndef REP_RB
#define REP_RB 1
#endif
#ifndef REP_R1
#define REP_R1 1
#endif
#ifndef REP_GU
#define REP_GU 1
#endif
#ifdef PROBE_TS
#define TSTAMP(k) do { if (blockIdx.x == 0 && threadIdx.x == 0) ((volatile unsigned long long*)(ws + WS_END))[k] = __builtin_amdgcn_s_memrealtime(); } while (0)
#else
#define TSTAMP(k) do {} while (0)
#endif
#ifdef USE_CG_SYNC
#define GRID_BAR() grid.sync()
#else
#define GRID_BAR() do { XcdBarrier b_; b_.bar = (unsigned*)(P.ws + WS_BAR); b_.x = xb_xcc_id(); b_.st = (volatile LAS unsigned*)(lds + 4 * 36864); xcd_barrier(b_); } while (0)
#endif
__global__ void __launch_bounds__(NTHREADS, 2) mk_fwd(Params P) {
    extern __shared__ __attribute__((aligned(16))) unsigned char lds_raw[];
    LAS unsigned char* lds = (LAS unsigned char*)lds_raw;
    cg::grid_group grid = cg::this_grid();
    unsigned char* ws = P.ws;
    volatile LAS unsigned* MISC = (volatile LAS unsigned*)(lds + 4 * 36864);
    if (threadIdx.x < 2) MISC[threadIdx.x] = 0u;
    __syncthreads();
    (void)xcd_barrier_post((unsigned*)(ws + WS_BAR), MISC);
    bf16_t* W_R12 = (bf16_t*)(ws + WS_W_R12); bf16_t* HX = (bf16_t*)(ws + WS_HX); bf16_t* YA = (bf16_t*)(ws + WS_YA); bf16_t* SCR = (bf16_t*)(ws + WS_SCR);

    TSTAMP(0);
    p0_phase(P, lds);
    grid.sync(); TSTAMP(1);
    norm_mod_phase(P.in[0], P.in[2], MT, HX, P.in[6], (const float*)(ws + WS_MODP), 8, P.in[5], 0, 1024, lds);
    {
        float* modf_ = (float*)(ws + WS_MODF); const float* modp = (const float*)(ws + WS_MODP);
        const int idx = blockIdx.x * NTHREADS + threadIdx.x;
        for (int i = idx; i < 3 * 6144; i += gridDim.x * NTHREADS) { const int r = i / 6144, jx = i % 6144; float s = P.in[5][jx];
            for (int p = 0; p < 8; ++p) s += modp[(size_t)(p * 3 + r) * 6144 + jx];
            modf_[i] = s; }
    }
    GRID_BAR(); TSTAMP(2);
    for (int rep_ = 0; rep_ < REP_R1; ++rep_) { run_gemm<1>(lds, HX, W_R12, MT, 4096, 1024, P); GRID_BAR(); } TSTAMP(3);
    for (int rep_ = 0; rep_ < REP_HA; ++rep_) { scan_phase<0, 0>(P, lds); GRID_BAR(); } TSTAMP(4);
    for (int rep_ = 0; rep_ < REP_HB; ++rep_) { scan_phase<0, 1>(P, lds); GRID_BAR(); } TSTAMP(5);
    norm_h_phase(P.out, P.in[11], YA);
    GRID_BAR(); TSTAMP(6);
    run_gemm<2>(lds, HX, W_R12 + (size_t)4096 * 1024, MT, 4096, 1024, P);
    GRID_BAR(); TSTAMP(7);
    for (int rep_ = 0; rep_ < REP_RA; ++rep_) { scan_phase<1, 0>(P, lds); GRID_BAR(); } TSTAMP(8);
    for (int rep_ = 0; rep_ < REP_RB; ++rep_) { scan_phase<1, 1>(P, lds); GRID_BAR(); } TSTAMP(9);
    norm_r_phase((const bf16_t*)P.out, SCR);
    p0b_phase(P, lds);
    GRID_BAR(); TSTAMP(10);
    run_gemm<3>(lds, HX, (const bf16_t*)(ws + WS_W_R3), MX, 5120, 1024, P);
    GRID_BAR(); TSTAMP(11);
    run_gemm<4>(lds, YA, (const bf16_t*)(ws + WS_W_PA), MX, 1024, 1024, P);
    run_gemm<5>(lds, SCR, (const bf16_t*)(ws + WS_W_PB), MX, 1024, 2048, P);
    GRID_BAR(); TSTAMP(12);
    run_gemm<6>(lds, HX, (const bf16_t*)(ws + WS_W_OUT), MX, 1024, 1024, P);
    GRID_BAR(); TSTAMP(13);
    norm_mod_phase(P.out, nullptr, MX, YA, P.in[7], (const float*)(ws + WS_MODF), 1, nullptr, 3072, 4096, lds);
    GRID_BAR(); TSTAMP(14);
    for (int rep_ = 0; rep_ < REP_GU; ++rep_) { run_gemm<7>(lds, YA, (const bf16_t*)(ws + WS_W_GU), MX, 5632, 1024, P); GRID_BAR(); } TSTAMP(15);
    run_gemm<8>(lds, SCR, (const bf16_t*)(ws + WS_W_DN), MX, 1024, DFF, P);
    GRID_BAR(); TSTAMP(16);
#ifdef REP_SYNC
    for (int rep_ = 0; rep_ < REP_SYNC; ++rep_) GRID_BAR();
#endif
    final_norm_phase(P.out, P.in[20]);
#ifdef PROBE_TS
    GRID_BAR(); TSTAMP(17);
    if (blockIdx.x == 0 && threadIdx.x == 0) { volatile unsigned long long* ts = (volatile unsigned long long*)(ws + WS_END);
        const float T1 = (float)(ts[PROBE_A1] - ts[PROBE_A0]) * 0.01f, T2 = (float)(ts[PROBE_B1] - ts[PROBE_B0]) * 0.01f;
        P.out[0] = T1; for (int i = 0; i < 10000; ++i) P.out[1024 + i] = T2; }
#endif
}

extern "C" void kernel_launch(void* const* d_in, const int* in_sizes, int n_in, void* d_out, int out_size, void* d_ws, size_t ws_size, hipStream_t stream) {
    static int grid_blocks = 0;
    if (grid_blocks == 0) {
        if (n_in != 21 || ws_size < WS_BAR + XCD_BAR_WORDS * 4) { fprintf(stderr, "kernel_launch: unexpected n_in %d / ws_size %zu (need %zu)\n", n_in, ws_size, (size_t)WS_END); grid_blocks = -1; return; }
        int dev = 0, cus = 0, per_cu = 0;
        hipGetDevice(&dev);
        hipDeviceGetAttribute(&cus, hipDeviceAttributeMultiprocessorCount, dev);
        hipFuncSetAttribute((const void*)mk_fwd, hipFuncAttributeMaxDynamicSharedMemorySize, LDS_BYTES);
        hipOccupancyMaxActiveBlocksPerMultiprocessor(&per_cu, (const void*)mk_fwd, NTHREADS, LDS_BYTES);
        if (per_cu < 1) per_cu = 1;
        grid_blocks = cus * per_cu;
        (void)hipGetLastError();
    }
    if (grid_blocks < 0) return;
    (void)hipMemsetAsync((unsigned char*)d_ws + WS_BAR, 0, XCD_BAR_WORDS * 4, stream);
    Params p{};
    for (int i = 0; i < 21; ++i) p.in[i] = (const float*)d_in[i];
    p.out = (float*)d_out; p.ws = (unsigned char*)d_ws;
    void* args[] = {&p};
    hipError_t e = hipLaunchCooperativeKernel((const void*)mk_fwd, dim3(grid_blocks), dim3(NTHREADS), args, LDS_BYTES, stream);
    if (e != hipSuccess) fprintf(stderr, "cooperative launch failed: %s (grid %d)\n", hipGetErrorString(e), grid_blocks);
}
```

```cpp
#include <hip/hip_runtime.h>
#include <hip/hip_cooperative_groups.h>
#include <cstdio>
#include <cstdint>
namespace cg = cooperative_groups;
namespace pg8 {
#define PG8_LAS __attribute__((address_space(3)))
typedef unsigned short bf16_t;
typedef short bf16x8 __attribute__((ext_vector_type(8)));
typedef float f32x4 __attribute__((ext_vector_type(4)));
typedef unsigned u32x4 __attribute__((ext_vector_type(4)));
constexpr int BM = 256, BK = 64, HALF = 128, HTB = HALF * BK * 2  , STAGE_BYTES = 8 * HTB, NXCD = 8, WGM = 8;

__host__ __device__ __forceinline__ int lds_byte(int r, int c) { const int st = (r >> 4) * 2 + (c >> 5), rr = r & 15, cc = c & 31, ob = rr * 64 + cc * 2; return st * 1024 + (ob ^ (((ob >> 9) & 1) << 5)); }
__host__ __device__ __forceinline__ void stage_rc(int b, int& R, int& C) { const int st = b / 1024, sb = b % 1024, swz = sb ^ (((sb >> 9) & 1) << 5); R = (st >> 1) * 16 + swz / 64; C = (st & 1) * 32 + (swz % 64) / 2; }
__host__ __device__ __forceinline__ int perm32(int rho) { const int n = rho >> 4, i = rho & 15; return 8 * (i >> 2) + 4 * n + (i & 3); }

struct Unit { int pm, pn; };
struct Gemm { const bf16_t* A; const bf16_t* Bt; int M, N, K; };

struct StaticOrder {
    int nM, nN, nwg, G, c;
    __host__ __device__ void init(int M, int N, int G_, int c_) { nM = M / BM; nN = N / BM; nwg = nM * nN; G = G_; c = c_; }
    __host__ __device__ bool next(int i, Unit& u) const {
        const long L = (long)i * G + c; if (L >= nwg) return false;
        int wgid = (int)L; { const int q = nwg / NXCD, r = nwg % NXCD, xcd = wgid % NXCD, off = wgid / NXCD; wgid = (xcd < r ? xcd * (q + 1) : r * (q + 1) + (xcd - r) * q) + off; }
        const int nig = WGM * nN, gid = wgid / nig, fm = gid * WGM, gsz = (nM - fm) < WGM ? (nM - fm) : WGM;
        u.pm = fm + ((wgid % nig) % gsz); u.pn = (wgid % nig) / gsz; return true;
    }
    __device__ __forceinline__ void a_ready(const Unit&) const {}
    __device__ __forceinline__ void done(const Unit&) const {}
};

__device__ __forceinline__ unsigned cvt_pk_bf16(float lo, float hi) { unsigned r; asm volatile("v_cvt_pk_bf16_f32 %0, %1, %2" : "=v"(r) : "v"(lo), "v"(hi)); return r; }
typedef float f32x2 __attribute__((ext_vector_type(2)));
template <class Epi, class Sched, bool ALIGN_EPI = false, bool SP2 = false>
__device__ __forceinline__ void gemm_phase(PG8_LAS unsigned char* lds, const Gemm g, const Sched& S, const Epi& E) {
    int tid_l = threadIdx.x; asm volatile("" : "+v"(tid_l));
    const int tid = tid_l, wid = __builtin_amdgcn_readfirstlane(tid >> 6), lane = tid & 63, wr = wid >> 2, wc = wid & 3, fr = lane & 15, fq = lane >> 4;
    const int K = g.K, nt = K / BK;
    unsigned voffA[2], voffB[2];
#pragma unroll
    for (int i = 0; i < 2; ++i) { int R, C; stage_rc(tid * 16 + i * 8192, R, C); const int Rb = Epi::PERM ? ((R & ~31) + perm32(R & 31)) : R;
        voffA[i] = (unsigned)(R * K + C) * 2u; voffB[i] = (unsigned)(Rb * K + C) * 2u; }
    const size_t kstep = (size_t)(BK * 2);
    const size_t hstep = (size_t)HALF * K * 2;
    const size_t tstep = 2 * hstep;
    const unsigned ldsw = (unsigned)wid * 1024u;
    const int aoff = lds_byte(wr * 64 + fr, fq * 8), boff = lds_byte(wc * 32 + fr, fq * 8);
#define PG8_SA(b, h) (((b) * 2 + (h)) * HTB)
#define PG8_SB(b, h) ((4 + (b) * 2 + (h)) * HTB)
#define PG8_STAGE(bufoff, gbase, voff) do { _Pragma("unroll") for (int _i = 0; _i < 2; ++_i) \
        __builtin_amdgcn_global_load_lds((const unsigned*)((const char*)(gbase) + (voff)[_i]), (PG8_LAS unsigned*)(lds + (bufoff) + ldsw + _i * 8192), 16, 0, 0); } while (0)
#define PG8_LDA(dst, b, h) do { _Pragma("unroll") for (int m = 0; m < 4; ++m) _Pragma("unroll") for (int k = 0; k < 2; ++k) dst[m][k] = *(const PG8_LAS bf16x8*)(lds + PG8_SA(b, h) + aoff + m * 2048 + k * 1024); } while (0)
#define PG8_LDB(dst, b, h) do { _Pragma("unroll") for (int n = 0; n < 2; ++n) _Pragma("unroll") for (int k = 0; k < 2; ++k) dst[n][k] = *(const PG8_LAS bf16x8*)(lds + PG8_SB(b, h) + boff + n * 2048 + k * 1024); } while (0)
#define PG8_MMA(ai, bj, At, Bt) do { __builtin_amdgcn_s_setprio(1); _Pragma("unroll") for (int m = 0; m < 4; ++m) _Pragma("unroll") for (int n = 0; n < 2; ++n) _Pragma("unroll") for (int k = 0; k < 2; ++k) \
        acc[ai][bj][m][n] = __builtin_amdgcn_mfma_f32_16x16x32_bf16(Bt[n][k], At[m][k], acc[ai][bj][m][n], 0, 0, 0); __builtin_amdgcn_s_setprio(0); } while (0)
#define PG8_WAIT_V(n) asm volatile("s_waitcnt vmcnt(" #n ")" ::: "memory")
#define PG8_WAIT_L(n) asm volatile("s_waitcnt lgkmcnt(" #n ")" ::: "memory")
#define PG8_BAR __builtin_amdgcn_s_barrier()
#define PG8_SCHED __builtin_amdgcn_sched_barrier(0)
    Unit cur, nxt; int ui = 0;
    if (!S.next(0, cur)) return;
    f32x4 acc[2][2][4][2];
#pragma unroll
    for (int a = 0; a < 2; ++a)
#pragma unroll
        for (int b = 0; b < 2; ++b)
#pragma unroll
            for (int m = 0; m < 4; ++m)
#pragma unroll
                for (int n = 0; n < 2; ++n) acc[a][b][m][n] = (f32x4){0.f, 0.f, 0.f, 0.f};
    bf16x8 At[4][2], B0[2][2], B1[2][2];
    const char* cA = (const char*)g.A + (size_t)cur.pm * tstep; const char* cB = (const char*)g.Bt + (size_t)cur.pn * tstep;
    S.a_ready(cur);
    if constexpr (SP2) {
        PG8_STAGE(PG8_SB(0, 0), cB, voffB); PG8_STAGE(PG8_SB(0, 1), cB + hstep, voffB); PG8_STAGE(PG8_SA(0, 0), cA, voffA); PG8_STAGE(PG8_SA(0, 1), cA + hstep, voffA);
        if (wr == 1) PG8_BAR;
        PG8_WAIT_V(2); PG8_BAR;
        PG8_STAGE(PG8_SB(1, 0), cB + kstep, voffB); PG8_STAGE(PG8_SA(1, 0), cA + kstep, voffA); PG8_STAGE(PG8_SB(1, 1), cB + hstep + kstep, voffB);
        PG8_WAIT_V(6); PG8_BAR;
    } else {
        PG8_STAGE(PG8_SB(0, 0), cB, voffB); PG8_STAGE(PG8_SA(0, 0), cA, voffA); PG8_STAGE(PG8_SB(0, 1), cB + hstep, voffB); PG8_STAGE(PG8_SA(0, 1), cA + hstep, voffA);
        if (wr == 1) PG8_BAR;
        PG8_WAIT_V(4); PG8_BAR;
        PG8_STAGE(PG8_SB(1, 0), cB + kstep, voffB); PG8_STAGE(PG8_SA(1, 0), cA + kstep, voffA); PG8_STAGE(PG8_SB(1, 1), cB + hstep + kstep, voffB);
        PG8_WAIT_V(6); PG8_BAR;
    }
    for (;;) {
        const bool has_next = S.next(ui + 1, nxt);
        const char* nA = has_next ? (const char*)g.A + (size_t)nxt.pm * tstep : cA; const char* nB = has_next ? (const char*)g.Bt + (size_t)nxt.pn * tstep : cB;
        for (int t = 0; t < nt; t += 2) {
            const bool last = (t == nt - 2);
            const char* a1 = cA + (size_t)(t + 1) * kstep;
            const char* a2 = last ? nA : cA + (size_t)(t + 2) * kstep; const char* b2 = last ? nB : cB + (size_t)(t + 2) * kstep;
            const char* a3 = a2 + kstep; const char* b3 = b2 + kstep;
            if (last && has_next) S.a_ready(nxt);
            if constexpr (SP2) {
            PG8_LDB(B0, 0, 0); PG8_LDB(B1, 0, 1); PG8_SCHED; PG8_LDA(At, 0, 0); PG8_STAGE(PG8_SA(1, 1), a1 + hstep, voffA);
            PG8_WAIT_V(8); PG8_WAIT_L(0); PG8_BAR; PG8_MMA(0, 0, At, B0); PG8_MMA(0, 1, At, B1); PG8_BAR; PG8_SCHED;
            PG8_LDA(At, 0, 1); PG8_STAGE(PG8_SB(0, 0), b2, voffB); PG8_STAGE(PG8_SB(0, 1), b2 + hstep, voffB); PG8_STAGE(PG8_SA(0, 0), a2, voffA);
            PG8_WAIT_V(8); PG8_WAIT_L(0); PG8_BAR; PG8_MMA(1, 0, At, B0); PG8_MMA(1, 1, At, B1); PG8_BAR; PG8_SCHED;
            PG8_LDB(B0, 1, 0); PG8_LDB(B1, 1, 1); PG8_SCHED; PG8_LDA(At, 1, 0); PG8_STAGE(PG8_SA(0, 1), a2 + hstep, voffA);
            PG8_WAIT_V(8); PG8_WAIT_L(0); PG8_BAR; PG8_MMA(0, 0, At, B0); PG8_MMA(0, 1, At, B1); PG8_BAR; PG8_SCHED;
            PG8_LDA(At, 1, 1); PG8_STAGE(PG8_SB(1, 0), b3, voffB); PG8_STAGE(PG8_SB(1, 1), b3 + hstep, voffB); PG8_STAGE(PG8_SA(1, 0), a3, voffA);
            PG8_WAIT_V(8); PG8_WAIT_L(0); PG8_BAR; PG8_MMA(1, 0, At, B0); PG8_MMA(1, 1, At, B1); PG8_BAR; PG8_SCHED;
            } else {
            PG8_LDB(B0, 0, 0); PG8_SCHED; PG8_LDA(At, 0, 0); PG8_STAGE(PG8_SA(1, 1), a1 + hstep, voffA);
            PG8_WAIT_L(8); PG8_BAR; PG8_WAIT_L(0); PG8_MMA(0, 0, At, B0); PG8_BAR; PG8_SCHED;
            PG8_LDB(B1, 0, 1); PG8_STAGE(PG8_SB(0, 0), b2, voffB);
            PG8_BAR; PG8_WAIT_L(0); PG8_MMA(0, 1, At, B1); PG8_BAR;
            PG8_LDA(At, 0, 1); PG8_STAGE(PG8_SA(0, 0), a2, voffA);
            PG8_BAR; PG8_WAIT_L(0); PG8_MMA(1, 0, At, B0); PG8_BAR; PG8_SCHED;
            PG8_STAGE(PG8_SB(0, 1), b2 + hstep, voffB);
            PG8_WAIT_V(6); PG8_BAR; PG8_MMA(1, 1, At, B1); PG8_BAR;
            PG8_LDB(B0, 1, 0); PG8_SCHED; PG8_LDA(At, 1, 0); PG8_STAGE(PG8_SA(0, 1), a2 + hstep, voffA);
            PG8_WAIT_L(8); PG8_BAR; PG8_WAIT_L(0); PG8_MMA(0, 0, At, B0); PG8_BAR; PG8_SCHED;
            PG8_LDB(B1, 1, 1); PG8_STAGE(PG8_SB(1, 0), b3, voffB);
            PG8_BAR; PG8_WAIT_L(0); PG8_MMA(0, 1, At, B1); PG8_BAR;
            PG8_LDA(At, 1, 1); PG8_STAGE(PG8_SA(1, 0), a3, voffA);
            PG8_BAR; PG8_WAIT_L(0); PG8_MMA(1, 0, At, B0); PG8_BAR; PG8_SCHED;
            PG8_STAGE(PG8_SB(1, 1), b3 + hstep, voffB);
            PG8_WAIT_V(6); PG8_BAR; PG8_MMA(1, 1, At, B1); PG8_BAR;
            }
        }
        if constexpr (ALIGN_EPI) { if (wr == 0) PG8_BAR; }
        if constexpr (!Epi::AFTER_DRAIN) { E(acc, cur, wr, wc, fr, fq); S.done(cur); }
        if (!has_next) break;
#pragma unroll
        for (int a = 0; a < 2; ++a)
#pragma unroll
            for (int b = 0; b < 2; ++b)
#pragma unroll
                for (int m = 0; m < 4; ++m)
#pragma unroll
                    for (int n = 0; n < 2; ++n) acc[a][b][m][n] = (f32x4){0.f, 0.f, 0.f, 0.f};
        cur = nxt; cA = nA; cB = nB; ++ui;
        if constexpr (ALIGN_EPI) { if (wr == 1) PG8_BAR; }
    }
    PG8_WAIT_V(0);
    if constexpr (!ALIGN_EPI) { if (wr == 0) PG8_BAR; }
    PG8_BAR;
    if constexpr (Epi::AFTER_DRAIN) { E.fused(acc, cur, wr, wc, fr, fq, lds, wid, lane); S.done(cur); }
#undef PG8_SA
#undef PG8_SB
#undef PG8_STAGE
#undef PG8_LDA
#undef PG8_LDB
#undef PG8_MMA
#undef PG8_WAIT_V
#undef PG8_WAIT_L
#undef PG8_BAR
#undef PG8_SCHED
}
}

#define LAS __attribute__((address_space(3)))
typedef unsigned short bf16_t;
typedef short bf16x8 __attribute__((ext_vector_type(8)));
typedef short s16x4 __attribute__((ext_vector_type(4)));
typedef float f32x4 __attribute__((ext_vector_type(4)));
typedef float f32x2 __attribute__((ext_vector_type(2)));
typedef float f32x16 __attribute__((ext_vector_type(16)));
typedef unsigned u32x4 __attribute__((ext_vector_type(4)));
typedef unsigned u32x2 __attribute__((ext_vector_type(2)));
typedef __bf16 bf16x2_t __attribute__((ext_vector_type(2)));
typedef _Float16 f16x2_t __attribute__((ext_vector_type(2)));

constexpr int DM = 1024, NBATCH = 2, SEQ = 8192, CTXL = 256;
constexpr int MX = NBATCH * SEQ;
constexpr int MC = NBATCH * CTXL;
constexpr int MT = MX + MC;
constexpr int DFF = 2816;
constexpr int NTHREADS = 512, NWAVES = 8;
constexpr int LDS_BYTES = 4 * 36864 + 1024;

constexpr size_t SLOT_ELEMS = (size_t)MT * 1024;
constexpr size_t WS_W_R12 = 0;
constexpr size_t WS_W_GU  = WS_W_R12 + (size_t)8192 * 1024 * 2;
constexpr size_t WS_W_DN  = WS_W_GU  + (size_t)5632 * 1024 * 2;
constexpr size_t WS_W_R3  = WS_W_DN  + (size_t)1024 * 2816 * 2;
constexpr size_t WS_W_PA  = WS_W_R3  + (size_t)5120 * 1024 * 2;
constexpr size_t WS_W_PB  = WS_W_PA  + (size_t)1024 * 1024 * 2;
constexpr size_t WS_W_OUT = WS_W_PB  + (size_t)1024 * 2048 * 2;
constexpr size_t WS_HX    = WS_W_OUT + (size_t)1024 * 1024 * 2;
constexpr size_t WS_YA    = WS_HX    + SLOT_ELEMS * 2;
constexpr size_t WS_SCR   = WS_YA    + (size_t)MX * 1024 * 2;
constexpr size_t WS_MODP  = WS_SCR   + 4 * SLOT_ELEMS * 2;
constexpr size_t WS_MODF  = WS_MODP  + (size_t)8 * 3 * 6144 * 4;
constexpr size_t WS_LBV   = WS_MODF  + (size_t)3 * 6144 * 4;
constexpr size_t WS_ROPE  = WS_LBV   + (size_t)2 * 1024 * 4;
constexpr size_t WS_CSH   = WS_ROPE  + (size_t)(4096 + 4096 + 2048 + 2048) * 4;
constexpr size_t WS_CSR   = WS_CSH   + (size_t)2 * 2 * 8 * 128 * 128 * 4;
constexpr size_t WS_GSUM  = WS_CSR   + (size_t)2 * 2 * 8 * 128 * 256 * 4;
constexpr size_t WS_END   = WS_GSUM  + (size_t)16 * 2 * 16 * 128 * 4;
constexpr size_t WS_BAR   = WS_END + 1024;
static_assert(WS_W_R3 - WS_W_R12 >= (size_t)32 * 2 * 8 * 16384 * 4, "retention segment states must fit");

struct Params { const float* in[21]; float* out; unsigned char* ws; };

__device__ __forceinline__ unsigned pkbf(float lo, float hi) { f32x2 v = {lo, hi}; bf16x2_t b = __builtin_convertvector(v, bf16x2_t); return __builtin_bit_cast(unsigned, b); }
__device__ __forceinline__ unsigned pkf16(float lo, float hi) { f32x2 v = {lo, hi}; f16x2_t b = __builtin_convertvector(v, f16x2_t); return __builtin_bit_cast(unsigned, b); }
__device__ __forceinline__ float bf2f(unsigned short u) { return __builtin_bit_cast(float, (unsigned)u << 16); }
__device__ __forceinline__ float bflo(unsigned u) { return __builtin_bit_cast(float, u << 16); }
__device__ __forceinline__ float bfhi(unsigned u) { return __builtin_bit_cast(float, u & 0xffff0000u); }
__device__ __forceinline__ float f16tof(unsigned short u) { return (float)__builtin_bit_cast(_Float16, u); }
__device__ __forceinline__ float sigmoidf_(float z) { return __builtin_amdgcn_rcpf(1.0f + __expf(-z)); }
__device__ __forceinline__ float siluf_(float z) { return z * sigmoidf_(z); }
__device__ __forceinline__ float wave_sum(float v) {
#pragma unroll
    for (int o = 1; o < 64; o <<= 1) v += __shfl_xor(v, o);
    return v;
}
#define LDS_WAIT() asm volatile("s_waitcnt lgkmcnt(0)" ::: "memory")

template <int mode> struct EpiAll {
    static constexpr bool PERM = true, AFTER_DRAIN = false;
    unsigned char* ws; const float* x; float* out;
    __device__ __forceinline__ void store8(bf16_t* p, const f32x4& a, const f32x4& b) const {
        u32x4 w; w.x = pkbf(a[0], a[1]); w.y = pkbf(a[2], a[3]); w.z = pkbf(b[0], b[1]); w.w = pkbf(b[2], b[3]); *(u32x4*)p = w;
    }
    __device__ __forceinline__ void operator()(const f32x4 (&acc)[2][2][4][2], const pg8::Unit& u, int wr, int wc, int fr, int fq) const {
        const int row0 = u.pm * 256 + wr * 64 + fr;
        const int cin = wc * 32 + 8 * fq;
        bf16_t* SCR = (bf16_t*)(ws + WS_SCR);
        if (mode == 1) {
            const int seg = u.pn >> 2, col0 = (u.pn & 3) * 256 + cin;
            bf16_t* base = SCR + (size_t)seg * SLOT_ELEMS;
            if (seg == 1 || seg == 2) {
                const float* lbv = (const float*)(ws + WS_LBV) + (seg - 1) * 1024;
#pragma unroll
                for (int bj = 0; bj < 2; ++bj) {
                    const f32x4 l0 = *(const f32x4*)(lbv + col0 + bj * 128), l1 = *(const f32x4*)(lbv + col0 + bj * 128 + 4);
#pragma unroll
                    for (int ai = 0; ai < 2; ++ai)
#pragma unroll
                        for (int m = 0; m < 4; ++m) {
                            float v[8];
#pragma unroll
                            for (int j = 0; j < 4; ++j) {
                                const float z0 = acc[ai][bj][m][0][j], z1 = acc[ai][bj][m][1][j];
                                v[j] = __logf(l0[j] + (1.0f - l0[j]) * sigmoidf_(z0));
                                v[4 + j] = __logf(l1[j] + (1.0f - l1[j]) * sigmoidf_(z1));
                            }
                            u32x4 w; w.x = pkf16(v[0], v[1]); w.y = pkf16(v[2], v[3]); w.z = pkf16(v[4], v[5]); w.w = pkf16(v[6], v[7]);
                            *(u32x4*)(base + (size_t)(row0 + ai * 128 + m * 16) * 1024 + col0 + bj * 128) = w;
                        }
                }
            } else {
                const float sc = seg == 0 ? 0.08838834764831845f : 1.0f;
#pragma unroll
                for (int ai = 0; ai < 2; ++ai)
#pragma unroll
                    for (int m = 0; m < 4; ++m)
#pragma unroll
                        for (int bj = 0; bj < 2; ++bj)
                            store8(base + (size_t)(row0 + ai * 128 + m * 16) * 1024 + col0 + bj * 128, acc[ai][bj][m][0] * sc, acc[ai][bj][m][1] * sc);
            }
        } else if (mode == 2) {
            if (u.pn < 8) {
                const int seg = u.pn >> 2, tile = u.pn & 3;
                bf16_t* base = SCR + (size_t)seg * SLOT_ELEMS;
                const float sc = seg == 0 ? 0.08838834764831845f : 1.0f;
                const int head = 2 * tile + (cin >> 6), e = cin & 63;
                const float* rp = (const float*)(ws + WS_ROPE);
                const bool latent = u.pm < 64;
#pragma unroll
                for (int ai = 0; ai < 2; ++ai)
#pragma unroll
                    for (int m = 0; m < 4; ++m) {
                        const int row = row0 + ai * 128 + m * 16;
                        f32x4 c0 = {1.f, 1.f, 1.f, 1.f}, c1 = c0, s0 = {0.f, 0.f, 0.f, 0.f}, s1 = s0;
                        if (latent) {
                            const int pos = row & (SEQ - 1), prow = pos >> 6, pcol = pos & 63;
                            const float* cp = e < 32 ? rp + prow * 32 + e : rp + 8192 + pcol * 32 + (e - 32);
                            const float* sp = e < 32 ? rp + 4096 + prow * 32 + e : rp + 8192 + 2048 + pcol * 32 + (e - 32);
                            c0 = *(const f32x4*)cp; c1 = *(const f32x4*)(cp + 4); s0 = *(const f32x4*)sp; s1 = *(const f32x4*)(sp + 4);
                        }
                        const f32x4 a0 = acc[ai][0][m][0] * sc, a1 = acc[ai][0][m][1] * sc, b0 = acc[ai][1][m][0] * sc, b1 = acc[ai][1][m][1] * sc;
                        bf16_t* p = base + (size_t)row * 1024 + head * 128 + e;
                        store8(p, a0 * c0 - b0 * s0, a1 * c1 - b1 * s1);
                        store8(p + 64, a0 * s0 + b0 * c0, a1 * s1 + b1 * c1);
                        asm volatile("" ::: "memory");
                    }
            } else {
                bf16_t* base = SCR + 2 * SLOT_ELEMS;
                const int col0 = (u.pn - 8) * 256 + cin;
#pragma unroll
                for (int ai = 0; ai < 2; ++ai)
#pragma unroll
                    for (int m = 0; m < 4; ++m)
#pragma unroll
                        for (int bj = 0; bj < 2; ++bj)
                            store8(base + (size_t)(row0 + ai * 128 + m * 16) * 2048 + col0 + bj * 128, acc[ai][bj][m][0], acc[ai][bj][m][1]);
            }
        } else if (mode == 3) {
            bf16_t* p; int ld, col0; bool gate;
            if (u.pn < 4) { p = (bf16_t*)(ws + WS_YA); ld = 1024; col0 = u.pn * 256 + cin; gate = true; }
            else if (u.pn < 12) { p = SCR; ld = 2048; col0 = (u.pn - 4) * 256 + cin; gate = true; }
            else { const int s = (u.pn - 12) >> 2; p = SCR + (size_t)(2 + s) * SLOT_ELEMS; ld = 1024; col0 = ((u.pn - 12) & 3) * 256 + cin; gate = false; }
#pragma unroll
            for (int ai = 0; ai < 2; ++ai)
#pragma unroll
                for (int m = 0; m < 4; ++m)
#pragma unroll
                    for (int bj = 0; bj < 2; ++bj) {
                        bf16_t* q = p + (size_t)(row0 + ai * 128 + m * 16) * ld + col0 + bj * 128;
                        f32x4 v0 = acc[ai][bj][m][0], v1 = acc[ai][bj][m][1];
                        if (gate) {
                            const u32x4 y = *(const u32x4*)q;
                            v0[0] = siluf_(v0[0]) * bflo(y.x); v0[1] = siluf_(v0[1]) * bfhi(y.x); v0[2] = siluf_(v0[2]) * bflo(y.y); v0[3] = siluf_(v0[3]) * bfhi(y.y);
                            v1[0] = siluf_(v1[0]) * bflo(y.z); v1[1] = siluf_(v1[1]) * bfhi(y.z); v1[2] = siluf_(v1[2]) * bflo(y.w); v1[3] = siluf_(v1[3]) * bfhi(y.w);
                        } else {
#pragma unroll
                            for (int j = 0; j < 4; ++j) { v0[j] = sigmoidf_(v0[j]); v1[j] = sigmoidf_(v1[j]); }
                        }
                        store8(q, v0, v1);
                        asm volatile("" ::: "memory");
                    }
        } else if (mode == 4 || mode == 5) {
            const bf16_t* sg = SCR + (size_t)(mode == 4 ? 2 : 3) * SLOT_ELEMS;
            bf16_t* mg = (bf16_t*)(ws + WS_HX);
            const int col0 = u.pn * 256 + cin;
#pragma unroll
            for (int ai = 0; ai < 2; ++ai)
#pragma unroll
                for (int m = 0; m < 4; ++m)
#pragma unroll
                    for (int bj = 0; bj < 2; ++bj) {
                        const size_t off = (size_t)(row0 + ai * 128 + m * 16) * 1024 + col0 + bj * 128;
                        const u32x4 g = *(const u32x4*)(sg + off);
                        f32x4 v0 = acc[ai][bj][m][0], v1 = acc[ai][bj][m][1];
                        v0[0] *= bflo(g.x); v0[1] *= bfhi(g.x); v0[2] *= bflo(g.y); v0[3] *= bfhi(g.y);
                        v1[0] *= bflo(g.z); v1[1] *= bfhi(g.z); v1[2] *= bflo(g.w); v1[3] *= bfhi(g.w);
                        if (mode == 4) { *(f32x4*)(out + off) = v0; *(f32x4*)(out + off + 4) = v1; }
                        else { v0 += *(const f32x4*)(out + off); v1 += *(const f32x4*)(out + off + 4); store8(mg + off, v0, v1); }
                        asm volatile("" ::: "memory");
                    }
        } else if (mode == 6 || mode == 8) {
            const int col0 = u.pn * 256 + cin;
            const float* res = mode == 6 ? x : out;
            const float* gv = (const float*)(ws + WS_MODF) + (size_t)(u.pm >= 32 ? 1 : 0) * 6144 + (mode == 6 ? 2048 : 5120);
#pragma unroll
            for (int bj = 0; bj < 2; ++bj) {
                const f32x4 g0 = *(const f32x4*)(gv + col0 + bj * 128), g1 = *(const f32x4*)(gv + col0 + bj * 128 + 4);
#pragma unroll
                for (int ai = 0; ai < 2; ++ai)
#pragma unroll
                    for (int m = 0; m < 4; ++m) {
                        const size_t off = (size_t)(row0 + ai * 128 + m * 16) * 1024 + col0 + bj * 128;
                        const f32x4 r0 = *(const f32x4*)(res + off), r1 = *(const f32x4*)(res + off + 4);
                        *(f32x4*)(out + off) = r0 + g0 * acc[ai][bj][m][0];
                        *(f32x4*)(out + off + 4) = r1 + g1 * acc[ai][bj][m][1];
                        asm volatile("" ::: "memory");
                    }
            }
        } else {
            const int col0 = u.pn * 128 + cin;
#pragma unroll
            for (int ai = 0; ai < 2; ++ai)
#pragma unroll
                for (int m = 0; m < 4; ++m) {
                    f32x4 v0, v1;
#pragma unroll
                    for (int j = 0; j < 4; ++j) { v0[j] = siluf_(acc[ai][0][m][0][j]) * acc[ai][1][m][0][j]; v1[j] = siluf_(acc[ai][0][m][1][j]) * acc[ai][1][m][1][j]; }
                    store8(SCR + (size_t)(row0 + ai * 128 + m * 16) * DFF + col0, v0, v1);
                }
        }
    }
};

__device__ __forceinline__ void p0_transpose_item(const float* W, int K, int N, bf16_t* WT, int drow0, int k0, int n0, LAS float* scr, int lane) {
#pragma unroll 8
    for (int i = 0; i < 32; ++i) { const int kk = 2 * i + (lane >> 5); scr[kk * 33 + (lane & 31)] = W[(size_t)(k0 + kk) * N + n0 + (lane & 31)]; }
    LDS_WAIT(); asm volatile("" ::: "memory");
    const int c = lane & 7;
#pragma unroll
    for (int j = 0; j < 4; ++j) { const int n = (lane >> 3) + 8 * j; const LAS float* s = scr + (8 * c) * 33 + n;
        u32x4 o; o.x = pkbf(s[0 * 33], s[1 * 33]); o.y = pkbf(s[2 * 33], s[3 * 33]); o.z = pkbf(s[4 * 33], s[5 * 33]); o.w = pkbf(s[6 * 33], s[7 * 33]);
        *(u32x4*)(WT + (size_t)(drow0 + n) * K + k0 + 8 * c) = o; }
    LDS_WAIT(); asm volatile("" ::: "memory");
}
__device__ __forceinline__ int win_map(int c) {
    if (c < 4096) return c;
    if (c < 5120) return 8192 + (c - 4096);
    if (c < 7168) { const int seg = (c - 5120) >> 10, cc = (c - 5120) & 1023, head = cc >> 7, half = (cc >> 6) & 1, e = cc & 63;
        return 4096 + seg * 1024 + 256 * (head >> 1) + 128 * half + 64 * (head & 1) + e; }
    if (c < 9216) return c - 1024;
    return c;
}
__device__ __forceinline__ void p0_phase(const Params& P, LAS unsigned char* lds) {
    int tid_l = threadIdx.x; asm volatile("" : "+v"(tid_l)); const int tid = tid_l, lane = tid & 63, wave = tid >> 6, G = gridDim.x;
    unsigned char* ws = P.ws;
    LAS float* scr = (LAS float*)(lds + wave * 16384);
    const int gw = blockIdx.x * NWAVES + wave, NGW = G * NWAVES;
    constexpr int I0 = 16 * 416, I1 = 16 * 32, I2 = 32 * 32, I3 = 16 * 32, I4 = 16 * 88, I5 = 16 * 88, I6 = 44 * 32;
    constexpr int NITEMS = I0 + I1 + I2 + I3;
    for (int it = gw; it < NITEMS; it += NGW) {
        int r = it;
        if (r < I0) { const int kb = r / 416, nb = r % 416; const int dr = win_map(nb * 32);
            p0_transpose_item(P.in[8], 1024, 13312, dr < 8192 ? (bf16_t*)(ws + WS_W_R12) : (bf16_t*)(ws + WS_W_R3), dr < 8192 ? dr : dr - 8192, kb * 64, nb * 32, scr, lane); continue; } r -= I0;
        if (r < I1) { const int kb = r / 32, nb = r % 32; p0_transpose_item(P.in[14], 1024, 1024, (bf16_t*)(ws + WS_W_PA), nb * 32, kb * 64, nb * 32, scr, lane); continue; } r -= I1;
        if (r < I2) { const int kb = r / 32, nb = r % 32; p0_transpose_item(P.in[15], 2048, 1024, (bf16_t*)(ws + WS_W_PB), nb * 32, kb * 64, nb * 32, scr, lane); continue; } r -= I2;
        { const int kb = r / 32, nb = r % 32; p0_transpose_item(P.in[16], 1024, 1024, (bf16_t*)(ws + WS_W_OUT), nb * 32, kb * 64, nb * 32, scr, lane); }
    }
    __syncthreads();
    LAS float* sv = (LAS float*)lds;
    float* modp = (float*)(ws + WS_MODP);
    for (int item = blockIdx.x; item < 96; item += G) {
        const int ks = item / 12, cb = item % 12, col = cb * 512 + tid;
        if (tid < 384) { const int r = tid >> 7, kk = tid & 127; const float cv = r < 2 ? P.in[1][r * 1024 + ks * 128 + kk] : P.in[3][ks * 128 + kk]; sv[tid] = cv / (1.0f + expf(-cv)); }
        __syncthreads();
        float a0 = 0.f, a1 = 0.f, a2 = 0.f;
        const float* wp = P.in[4] + (size_t)(ks * 128) * 6144 + col;
#pragma unroll 8
        for (int kk = 0; kk < 128; ++kk) { const float w = wp[(size_t)kk * 6144]; a0 += sv[kk] * w; a1 += sv[128 + kk] * w; a2 += sv[256 + kk] * w; }
        modp[(size_t)(ks * 3 + 0) * 6144 + col] = a0; modp[(size_t)(ks * 3 + 1) * 6144 + col] = a1; modp[(size_t)(ks * 3 + 2) * 6144 + col] = a2;
        __syncthreads();
    }
    const int gt = blockIdx.x * NTHREADS + tid, NGT = G * NTHREADS;
    float* lbv = (float*)(ws + WS_LBV); float* rp = (float*)(ws + WS_ROPE);
    for (int i = gt; i < 2048; i += NGT) { const float* s = i < 1024 ? P.in[9] : P.in[10]; const int k = i & 1023; const float a0 = s[k], a1 = s[1024 + k]; lbv[i] = 1.0f / (1.0f + expf(a1 - a0)); }
    for (int i = gt; i < 4096 + 2048; i += NGT) {
        const bool isrow = i < 4096; const int ii = isrow ? i : i - 4096; const int p = ii >> 5, f = ii & 31;
        const float fr = powf(10000.0f, -(float)f / 32.0f); const float ang = (float)p * fr; float sn, cs; sincosf(ang, &sn, &cs);
        if (isrow) { rp[ii] = cs; rp[4096 + ii] = sn; } else { rp[8192 + ii] = cs; rp[8192 + 2048 + ii] = sn; }
    }
}

__device__ __forceinline__ void p0b_phase(const Params& P, LAS unsigned char* lds) {
    int tid_l = threadIdx.x; asm volatile("" : "+v"(tid_l)); const int tid = tid_l, lane = tid & 63, wave = tid >> 6, G = gridDim.x;
    unsigned char* ws = P.ws;
    LAS float* scr = (LAS float*)(lds + wave * 16384);
    const int gw = blockIdx.x * NWAVES + wave, NGW = G * NWAVES;
    constexpr int I4 = 16 * 88, I5 = 16 * 88, I6 = 44 * 32;
    for (int it = gw; it < I4 + I5 + I6; it += NGW) {
        int r = it;
        if (r < I4) { const int kb = r / 88, nb = r % 88, c = nb * 32; p0_transpose_item(P.in[17], 1024, DFF, (bf16_t*)(ws + WS_W_GU), 256 * (c >> 7) + (c & 127), kb * 64, c, scr, lane); continue; } r -= I4;
        if (r < I5) { const int kb = r / 88, nb = r % 88, c = nb * 32; p0_transpose_item(P.in[18], 1024, DFF, (bf16_t*)(ws + WS_W_GU), 256 * (c >> 7) + 128 + (c & 127), kb * 64, c, scr, lane); continue; } r -= I5;
        { const int kb = r / 32, nb = r % 32; p0_transpose_item(P.in[19], DFF, 1024, (bf16_t*)(ws + WS_W_DN), nb * 32, kb * 64, nb * 32, scr, lane); }
    }
}

__device__ __forceinline__ void norm_mod_phase(const float* src0, const float* src1, int nrows, bf16_t* dst, const float* w,
                                               const float* modsrc, int nparts, const float* bias, int sh_off, int sc_off, LAS unsigned char* lds) {
    int tid_l = threadIdx.x; asm volatile("" : "+v"(tid_l)); const int tid = tid_l, lane = tid & 63, wave = tid >> 6, G = gridDim.x;
    LAS float* CA = (LAS float*)lds;
    LAS float* CB = CA + 3072;
    for (int idx = tid; idx < 3072; idx += NTHREADS) {
        const int r = idx >> 10, k = idx & 1023;
        float sh = bias ? bias[sh_off + k] : 0.f, sc = bias ? bias[sc_off + k] : 0.f;
        for (int p = 0; p < nparts; ++p) { sh += modsrc[(size_t)(p * 3 + r) * 6144 + sh_off + k]; sc += modsrc[(size_t)(p * 3 + r) * 6144 + sc_off + k]; }
        CA[idx] = w[k] * (1.0f + sc); CB[idx] = sh;
    }
    __syncthreads();
    for (int row = blockIdx.x * NWAVES + wave; row < nrows; row += G * NWAVES) {
        const float* xr = row < MX ? src0 + (size_t)row * 1024 : src1 + (size_t)(row - MX) * 1024;
        const int r = row < MX ? (row >= SEQ ? 1 : 0) : 2;
        f32x4 v[4]; float s = 0.f;
#pragma unroll
        for (int j = 0; j < 4; ++j) { v[j] = *(const f32x4*)(xr + 4 * lane + 256 * j); s += (v[j][0] * v[j][0] + v[j][1] * v[j][1]) + (v[j][2] * v[j][2] + v[j][3] * v[j][3]); }
        const float rstd = rsqrtf(wave_sum(s) * (1.0f / 1024.0f) + 1e-6f);
#pragma unroll
        for (int j = 0; j < 4; ++j) {
            const f32x4 a = *(const LAS f32x4*)(CA + r * 1024 + 4 * lane + 256 * j), b = *(const LAS f32x4*)(CB + r * 1024 + 4 * lane + 256 * j);
            const f32x4 y = v[j] * rstd * a + b;
            u32x2 o; o.x = pkbf(y[0], y[1]); o.y = pkbf(y[2], y[3]);
            *(u32x2*)(dst + (size_t)row * 1024 + 4 * lane + 256 * j) = o;
        }
    }
}
__device__ __forceinline__ void final_norm_phase(float* io, const float* w) {
    int tid_l = threadIdx.x; asm volatile("" : "+v"(tid_l)); const int tid = tid_l, lane = tid & 63, wave = tid >> 6, G = gridDim.x;
    for (int row = blockIdx.x * NWAVES + wave; row < MX; row += G * NWAVES) {
        float* xr = io + (size_t)row * 1024;
        f32x4 v[4]; float s = 0.f;
#pragma unroll
        for (int j = 0; j < 4; ++j) { v[j] = *(const f32x4*)(xr + 4 * lane + 256 * j); s += (v[j][0] * v[j][0] + v[j][1] * v[j][1]) + (v[j][2] * v[j][2] + v[j][3] * v[j][3]); }
        const float rstd = rsqrtf(wave_sum(s) * (1.0f / 1024.0f) + 1e-6f);
#pragma unroll
        for (int j = 0; j < 4; ++j) { const f32x4 a = *(const f32x4*)(w + 4 * lane + 256 * j); *(f32x4*)(xr + 4 * lane + 256 * j) = v[j] * rstd * a; }
    }
}
__device__ __forceinline__ void norm_h_phase(const float* oh, const float* nw, bf16_t* ya) {
    int tid_l = threadIdx.x; asm volatile("" : "+v"(tid_l)); const int tid = tid_l, lane = tid & 63, wave = tid >> 6, G = gridDim.x;
    for (int row = blockIdx.x * NWAVES + wave; row < MX; row += G * NWAVES) {
        const float* xr = oh + (size_t)row * 1024 + 16 * lane;
        f32x4 v[4]; float s = 0.f;
#pragma unroll
        for (int j = 0; j < 4; ++j) { v[j] = *(const f32x4*)(xr + 4 * j); s += (v[j][0] * v[j][0] + v[j][1] * v[j][1]) + (v[j][2] * v[j][2] + v[j][3] * v[j][3]); }
        s += __shfl_xor(s, 1); s += __shfl_xor(s, 2); s += __shfl_xor(s, 4);
        const float rstd = rsqrtf(s * (1.0f / 128.0f) + 1e-6f);
        u32x4 o[2];
#pragma unroll
        for (int j = 0; j < 4; ++j) { const f32x4 a = *(const f32x4*)(nw + 16 * lane + 4 * j); const f32x4 y = v[j] * rstd * a;
            o[j >> 1][(j & 1) * 2] = pkbf(y[0], y[1]); o[j >> 1][(j & 1) * 2 + 1] = pkbf(y[2], y[3]); }
        *(u32x4*)(ya + (size_t)row * 1024 + 16 * lane) = o[0]; *(u32x4*)(ya + (size_t)row * 1024 + 16 * lane + 8) = o[1];
    }
}
__device__ __forceinline__ void norm_r_phase(const bf16_t* orr, bf16_t* yb) {
    int tid_l = threadIdx.x; asm volatile("" : "+v"(tid_l)); const int tid = tid_l, lane = tid & 63, wave = tid >> 6, G = gridDim.x;
    for (int row = blockIdx.x * NWAVES + wave; row < MX; row += G * NWAVES) {
        const bf16_t* xr = orr + (size_t)row * 2048 + 32 * lane;
        float v[32]; float s = 0.f;
#pragma unroll
        for (int j = 0; j < 4; ++j) { const u32x4 q = *(const u32x4*)(xr + 8 * j);
#pragma unroll
            for (int e = 0; e < 4; ++e) { v[8 * j + 2 * e] = bflo(q[e]); v[8 * j + 2 * e + 1] = bfhi(q[e]); } }
#pragma unroll
        for (int e = 0; e < 32; ++e) s += v[e];
        s += __shfl_xor(s, 1); s += __shfl_xor(s, 2); s += __shfl_xor(s, 4);
        const float mu = s * (1.0f / 256.0f); float q2 = 0.f;
#pragma unroll
        for (int e = 0; e < 32; ++e) { v[e] -= mu; q2 += v[e] * v[e]; }
        q2 += __shfl_xor(q2, 1); q2 += __shfl_xor(q2, 2); q2 += __shfl_xor(q2, 4);
        const float rstd = rsqrtf(q2 * (1.0f / 256.0f) + 1e-5f);
#pragma unroll
        for (int j = 0; j < 4; ++j) { u32x4 o;
#pragma unroll
            for (int e = 0; e < 4; ++e) o[e] = pkbf(v[8 * j + 2 * e] * rstd, v[8 * j + 2 * e + 1] * rstd);
            *(u32x4*)(yb + (size_t)row * 2048 + 32 * lane + 8 * j) = o; }
    }
}

#define MFMA32(a, b, c) __builtin_amdgcn_mfma_f32_32x32x16_bf16((a), (b), (c), 0, 0, 0)
__device__ __forceinline__ int crow(int reg, int h) { return (reg & 3) + 8 * (reg >> 2) + 4 * h; }
__device__ __forceinline__ bf16x8 pack_step(const f32x16& x, int s) {
    u32x4 p; p.x = pkbf(x[8 * s], x[8 * s + 1]); p.y = pkbf(x[8 * s + 2], x[8 * s + 3]); p.z = pkbf(x[8 * s + 4], x[8 * s + 5]); p.w = pkbf(x[8 * s + 6], x[8 * s + 7]);
    return __builtin_bit_cast(bf16x8, p);
}
constexpr int SB_QT = 0, SB_KT = 8704, SB_KTT = 17408, SB_V = 27648, SB_G = 36352, SB_BYTES = 36864;
constexpr int QS = 136, TS = 40;
constexpr int NSEG_H = 16, NSEG_R = 8;

struct ScanItem {
    const bf16_t* q;
    const unsigned short *kl0, *kl1;
    const bf16_t* v; int ldv;
    float lg0, lg1;
    int row_base, nchunk;
    const float *ctx0, *ctx1;
    const float *us0, *us1;
    const float *gs0, *gs1;
    float segdec0, segdec1;
    int m, nseg;
    float *so0, *so1;
    float *go0, *go1;
    float* of32; bf16_t* obf; int ldo;
    int dry;
};

template <int KIND, int PASS>
__device__ __forceinline__ void scan_item(LAS unsigned char* lds, const ScanItem& a) {
    int tid_l = threadIdx.x; asm volatile("" : "+v"(tid_l)); const int tid = tid_l, dir = __builtin_amdgcn_readfirstlane(tid >> 8), t = tid & 255, w4 = __builtin_amdgcn_readfirstlane(t >> 6), lane = t & 63, r = lane & 31, hh = lane >> 5;
    const int n = a.nchunk, d = 32 * w4 + r;
    const unsigned short* klp = dir ? a.kl1 : a.kl0;
    const float lg = dir ? a.lg1 : a.lg0;
    f32x16 S[4];
    if (PASS == 1) {
        const float* U = (dir ? a.us1 : a.us0) + (size_t)a.m * 16384;
#pragma unroll
        for (int g = 0; g < 4; ++g)
#pragma unroll
            for (int i = 0; i < 16; ++i) S[g][i] = U[(32 * g + crow(i, hh)) * 128 + 32 * w4 + r];
    } else {
#pragma unroll
        for (int g = 0; g < 4; ++g)
#pragma unroll
            for (int i = 0; i < 16; ++i) S[g][i] = 0.f;
    }
    float gtot = 0.f;
    u32x4 rq0, rq1, rk0, rk1, rv0, rv1;
    const int vs = t >> 3, vq = t & 7;
#define LOAD_RAW(jn) do { \
        const int c_ = dir ? n - 1 - (jn) : (jn); \
        const size_t row_ = (size_t)a.row_base + 32 * c_ + (dir ? 31 - vs : vs); \
        if (PASS == 1) { rq0 = *(const u32x4*)(a.q + row_ * 1024 + 16 * vq); rq1 = *(const u32x4*)(a.q + row_ * 1024 + 16 * vq + 8); } \
        rk0 = *(const u32x4*)(klp + row_ * 1024 + 16 * vq); rk1 = *(const u32x4*)(klp + row_ * 1024 + 16 * vq + 8); \
        rv0 = *(const u32x4*)(a.v + row_ * a.ldv + 16 * vq); rv1 = *(const u32x4*)(a.v + row_ * a.ldv + 16 * vq + 8); \
    } while (0)
    LOAD_RAW(0);
    for (int j = 0; j < n; ++j) {
        LAS unsigned char* L = lds + (dir * 2 + (j & 1)) * SB_BYTES;
        LAS bf16_t* QT = (LAS bf16_t*)(L + SB_QT); LAS bf16_t* KT = (LAS bf16_t*)(L + SB_KT);
        LAS bf16_t* KTT = (LAS bf16_t*)(L + SB_KTT); LAS bf16_t* VR = (LAS bf16_t*)(L + SB_V);
        LAS float* GV = (LAS float*)(L + SB_G);
        if (PASS == 1) { *(LAS u32x4*)(QT + vs * QS + 16 * vq) = rq0; *(LAS u32x4*)(QT + vs * QS + 16 * vq + 8) = rq1; }
        *(LAS u32x4*)(KT + vs * QS + 16 * vq) = rk0; *(LAS u32x4*)(KT + vs * QS + 16 * vq + 8) = rk1;
        *(LAS u32x4*)(VR + vs * QS + 16 * vq) = rv0; *(LAS u32x4*)(VR + vs * QS + 16 * vq + 8) = rv1;
        asm volatile("s_waitcnt lgkmcnt(0)" ::: "memory"); __builtin_amdgcn_s_barrier(); asm volatile("" ::: "memory");
        {
            float b[16], kk[16]; unsigned short rk[16];
#pragma unroll
            for (int ii = 0; ii < 16; ++ii) rk[ii] = KT[(16 * hh + ii) * QS + d];
            if (KIND == 0) {
                float run = 0.f;
#pragma unroll
                for (int ii = 0; ii < 16; ++ii) { const float lf = f16tof(rk[ii]); run += lf; b[ii] = run; kk[ii] = 1.0f - __expf(lf); }
                const float other = __shfl_xor(run, 32);
                const float off = hh ? other : 0.f;
#pragma unroll
                for (int ii = 0; ii < 16; ++ii) b[ii] += off;
                if (hh == 0) GV[d] = __expf(run + other);
                gtot += run + other;
            } else {
#pragma unroll
                for (int ii = 0; ii < 16; ++ii) { b[ii] = (float)(16 * hh + ii + 1) * lg; kk[ii] = bf2f(rk[ii]); }
                if (hh == 0) GV[d] = __expf(32.0f * lg);
            }
            unsigned kt[8];
#pragma unroll
            for (int ii = 0; ii < 16; ii += 2) {
                const float e0 = __expf(b[ii]), e1 = __expf(b[ii + 1]);
                const unsigned kq = pkbf(kk[ii] * __builtin_amdgcn_rcpf(e0), kk[ii + 1] * __builtin_amdgcn_rcpf(e1));
                kt[ii >> 1] = kq;
                const int i = 16 * hh + ii;
                if (PASS == 1) {
                    const unsigned qq = pkbf(bf2f(QT[i * QS + d]) * e0, bf2f(QT[(i + 1) * QS + d]) * e1);
                    QT[i * QS + d] = (bf16_t)(qq & 0xffffu); QT[(i + 1) * QS + d] = (bf16_t)(qq >> 16);
                    KT[i * QS + d] = (bf16_t)(kq & 0xffffu); KT[(i + 1) * QS + d] = (bf16_t)(kq >> 16);
                }
            }
            *(LAS u32x4*)(KTT + d * TS + 16 * hh) = (u32x4){kt[0], kt[1], kt[2], kt[3]};
            *(LAS u32x4*)(KTT + d * TS + 16 * hh + 8) = (u32x4){kt[4], kt[5], kt[6], kt[7]};
        }
        if (PASS == 1 && j == (n >> 1)) asm volatile("s_waitcnt vmcnt(0)" ::: "memory");
        asm volatile("s_waitcnt lgkmcnt(0)" ::: "memory"); __builtin_amdgcn_s_barrier(); asm volatile("" ::: "memory");
        if (j + 1 < n) LOAD_RAW(j + 1);
        f32x4 old[4];
        const int c_out = dir ? n - 1 - j : j;
        const size_t row_out = (size_t)a.row_base + 32 * c_out + (dir ? 31 - r : r);
        if (PASS == 1) {
            if (j >= (n >> 1)) {
                if (KIND == 0) { const float* pb = a.of32 + row_out * a.ldo + 32 * w4 + 4 * hh;
#pragma unroll
                    for (int g = 0; g < 4; ++g) old[g] = *(const f32x4*)(pb + 8 * g); }
                else { const bf16_t* pb = a.obf + row_out * a.ldo + 32 * w4 + 4 * hh;
#pragma unroll
                    for (int g = 0; g < 4; ++g) { const u32x2 q2 = *(const u32x2*)(pb + 8 * g); old[g] = (f32x4){bflo(q2.x), bfhi(q2.x), bflo(q2.y), bfhi(q2.y)}; } }
            } else {
#pragma unroll
                for (int g = 0; g < 4; ++g) old[g] = (f32x4){0.f, 0.f, 0.f, 0.f};
            }
        }
#define OUTPUT_STORE() do { \
            if (KIND == 0) { float* pb = a.of32 + row_out * a.ldo + 32 * w4 + 4 * hh; \
                _Pragma("unroll") for (int g = 0; g < 4; ++g) *(f32x4*)(pb + 8 * g) = (f32x4){o[4 * g], o[4 * g + 1], o[4 * g + 2], o[4 * g + 3]} + old[g]; } \
            else { bf16_t* pb = a.obf + row_out * a.ldo + 32 * w4 + 4 * hh; \
                _Pragma("unroll") for (int g = 0; g < 4; ++g) { u32x2 w_; w_.x = pkbf(o[4 * g] + old[g][0], o[4 * g + 1] + old[g][1]); w_.y = pkbf(o[4 * g + 2] + old[g][2], o[4 * g + 3] + old[g][3]); *(u32x2*)(pb + 8 * g) = w_; } } \
        } while (0)
        bf16x8 vb[2];
#pragma unroll
        for (int ks = 0; ks < 2; ++ks) {
            u32x4 p;
#pragma unroll
            for (int jj = 0; jj < 8; jj += 2) {
                const unsigned lo = VR[(16 * ks + 8 * (jj >> 2) + 4 * hh + (jj & 3)) * QS + 32 * w4 + r];
                const unsigned hi = VR[(16 * ks + 8 * (jj >> 2) + 4 * hh + (jj & 3) + 1) * QS + 32 * w4 + r];
                p[jj >> 1] = lo | (hi << 16);
            }
            vb[ks] = __builtin_bit_cast(bf16x8, p);
        }
        if (PASS == 1) {
            f32x16 at;
#pragma unroll
            for (int i = 0; i < 16; ++i) at[i] = 0.f;
#pragma unroll
            for (int ks = 0; ks < 8; ++ks) {
                const bf16x8 ka = *(const LAS bf16x8*)(KT + r * QS + 16 * ks + 8 * hh);
                const bf16x8 qb = *(const LAS bf16x8*)(QT + r * QS + 16 * ks + 8 * hh);
                at = MFMA32(ka, qb, at);
            }
#pragma unroll
            for (int i = 0; i < 16; ++i) if (crow(i, hh) > r) at[i] = 0.f;
            f32x16 o;
#pragma unroll
            for (int i = 0; i < 16; ++i) o[i] = 0.f;
#pragma unroll
            for (int ks = 0; ks < 2; ++ks) o = MFMA32(vb[ks], pack_step(at, ks), o);
#pragma unroll
            for (int g = 0; g < 4; ++g)
#pragma unroll
                for (int ks = 0; ks < 2; ++ks) {
                    const s16x4 qlo = *(const LAS s16x4*)(QT + r * QS + 32 * g + 16 * ks + 4 * hh), qhi = *(const LAS s16x4*)(QT + r * QS + 32 * g + 16 * ks + 8 + 4 * hh);
                    const bf16x8 qa = __builtin_shufflevector(qlo, qhi, 0, 1, 2, 3, 4, 5, 6, 7);
                    o = MFMA32(pack_step(S[g], ks), qa, o);
                }
            OUTPUT_STORE();
        }
#pragma unroll
        for (int g = 0; g < 4; ++g) {
#pragma unroll
            for (int ks = 0; ks < 2; ++ks) {
                const s16x4 klo = *(const LAS s16x4*)(KTT + (32 * g + r) * TS + 16 * ks + 4 * hh), khi = *(const LAS s16x4*)(KTT + (32 * g + r) * TS + 16 * ks + 8 + 4 * hh);
                const bf16x8 ka = __builtin_shufflevector(klo, khi, 0, 1, 2, 3, 4, 5, 6, 7);
                S[g] = MFMA32(ka, vb[ks], S[g]);
            }
#pragma unroll
            for (int q4 = 0; q4 < 4; ++q4) { const f32x4 gv = *(const LAS f32x4*)(GV + 32 * g + 8 * q4 + 4 * hh);
#pragma unroll
                for (int jj = 0; jj < 4; ++jj) S[g][4 * q4 + jj] *= gv[jj]; }
        }
    }
#undef LOAD_RAW
#undef OUTPUT_STORE
    if (PASS == 0) {
        float* so = dir ? a.so1 : a.so0;
#pragma unroll
        for (int g = 0; g < 4; ++g)
#pragma unroll
            for (int i = 0; i < 16; ++i) so[(32 * g + crow(i, hh)) * 128 + 32 * w4 + r] = S[g][i];
        float* go = dir ? a.go1 : a.go0;
        if (KIND == 0 && go && hh == 0) go[d] = gtot;
    }
    __syncthreads();
}

__device__ __forceinline__ float log_sigmoid_(float th) { return -log1pf(expf(-th)); }

template <int KIND>
__device__ __forceinline__ void fold_phase(const Params& P) {
    unsigned char* ws = P.ws;
    constexpr int NSEG = KIND == 0 ? NSEG_H : NSEG_R, NSEQ = KIND == 0 ? 16 : 32, SEGLEN = SEQ / NSEG;
    float* USEG = (float*)(ws + (KIND == 0 ? WS_YA : WS_W_R12));
    const float* CS = (const float*)(ws + (KIND == 0 ? WS_CSH : WS_CSR));
    const float* GS = (const float*)(ws + WS_GSUM);
    const int total = NSEQ * 2 * 4096;
    for (int idx = blockIdx.x * NTHREADS + threadIdx.x; idx < total; idx += gridDim.x * NTHREADS) {
        const int sd = idx >> 12, quad = idx & 4095, d = quad >> 5, c4 = (quad & 31) * 4, dir = sd & 1, sq = sd >> 1;
        f32x4 S = *(const f32x4*)(CS + (size_t)sd * 16384 + d * 128 + c4);
        float* U = USEG + (size_t)sd * NSEG * 16384 + d * 128 + c4;
        float sdec = 0.f;
        if (KIND == 1) { const int h = (sq >> 1) & 7; sdec = __expf(log_sigmoid_(dir ? P.in[13][h] : P.in[12][h]) * (float)SEGLEN); }
        f32x4 u[NSEG]; float dec[NSEG];
#pragma unroll
        for (int q = 0; q < NSEG; ++q) { const int mm = dir ? NSEG - 1 - q : q; u[q] = *(const f32x4*)(U + (size_t)mm * 16384);
            dec[q] = KIND == 0 ? __expf(GS[((size_t)sd * NSEG + mm) * 128 + d]) : sdec; }
#pragma unroll
        for (int q = 0; q < NSEG; ++q) { const int mm = dir ? NSEG - 1 - q : q; *(f32x4*)(U + (size_t)mm * 16384) = S; S = S * dec[q] + u[q]; }
    }
}

template <int KIND, int PASS>
__device__ __forceinline__ void scan_phase(const Params& P, LAS unsigned char* lds) {
    unsigned char* ws = P.ws;
    bf16_t* SCR = (bf16_t*)(ws + WS_SCR);
    constexpr int NSEG = KIND == 0 ? NSEG_H : NSEG_R, NSEQ = KIND == 0 ? 16 : 32, SEGLEN = SEQ / NSEG;
    const int nitems = PASS == 0 ? NSEQ * NSEG + NSEQ : NSEQ * NSEG;
    float* USEG = (float*)(ws + (KIND == 0 ? WS_YA : WS_W_R12));
    float* CS = (float*)(ws + (KIND == 0 ? WS_CSH : WS_CSR));
    float* GS = (float*)(ws + WS_GSUM);
    for (int it = blockIdx.x; it < nitems; it += gridDim.x) {
        const bool isctx = it >= NSEQ * NSEG;
        const int sq = isctx ? it - NSEQ * NSEG : it / NSEG, m = isctx ? 0 : it % NSEG;
        ScanItem a;
        int b, h;
        if (KIND == 0) {
            b = sq >> 3; h = sq & 7;
            a.q = SCR + 128 * h;
            a.kl0 = (const unsigned short*)(SCR + SLOT_ELEMS) + 128 * h; a.kl1 = (const unsigned short*)(SCR + 2 * SLOT_ELEMS) + 128 * h;
            a.v = SCR + 3 * SLOT_ELEMS + 128 * h; a.ldv = 1024; a.lg0 = 0.f; a.lg1 = 0.f; a.segdec0 = 0.f; a.segdec1 = 0.f;
            a.of32 = P.out + 128 * h; a.obf = nullptr; a.ldo = 1024;
        } else {
            const int hv = sq & 1; b = sq >> 4; h = (sq >> 1) & 7;
            a.q = SCR + 128 * h;
            a.kl0 = (const unsigned short*)(SCR + SLOT_ELEMS) + 128 * h; a.kl1 = a.kl0;
            a.v = SCR + 2 * SLOT_ELEMS + 256 * h + 128 * hv; a.ldv = 2048;
            a.lg0 = log_sigmoid_(P.in[12][h]); a.lg1 = log_sigmoid_(P.in[13][h]); a.segdec0 = a.lg0 * (float)SEGLEN; a.segdec1 = a.lg1 * (float)SEGLEN;
            a.of32 = nullptr; a.obf = (bf16_t*)P.out + 256 * h + 128 * hv; a.ldo = 2048;
        }
        a.row_base = isctx ? MX + b * CTXL : b * SEQ + m * SEGLEN; a.nchunk = isctx ? CTXL / 32 : SEGLEN / 32;
        a.ctx0 = CS + (size_t)(sq * 2 + 0) * 16384; a.ctx1 = CS + (size_t)(sq * 2 + 1) * 16384;
        a.us0 = USEG + (size_t)(sq * 2 + 0) * NSEG * 16384; a.us1 = USEG + (size_t)(sq * 2 + 1) * NSEG * 16384;
        a.gs0 = GS + (size_t)(sq * 2 + 0) * NSEG * 128; a.gs1 = GS + (size_t)(sq * 2 + 1) * NSEG * 128;
        a.m = m; a.nseg = NSEG; a.dry = 0;
        if (isctx) { a.so0 = CS + (size_t)(sq * 2 + 0) * 16384; a.so1 = CS + (size_t)(sq * 2 + 1) * 16384; a.go0 = nullptr; a.go1 = nullptr; }
        else { a.so0 = USEG + ((size_t)(sq * 2 + 0) * NSEG + m) * 16384; a.so1 = USEG + ((size_t)(sq * 2 + 1) * NSEG + m) * 16384;
               a.go0 = GS + ((size_t)(sq * 2 + 0) * NSEG + m) * 128; a.go1 = GS + ((size_t)(sq * 2 + 1) * NSEG + m) * 128; }
        scan_item<KIND, PASS>(lds, a);
    }
}

#define XB_TMO      128
#define XB_XCNT(j)  (256  + 64 * (j))
#define XB_XSUB(j)  (1280 + 64 * (j))
#define XB_XGEN(j)  (2304 + 64 * (j))
#define XB_TOP      3328
#define XB_TOPGEN   3392
#define XCD_BAR_WORDS 3456
#define XB_SPIN_CAP (1u << 18)

__device__ __forceinline__ unsigned xb_ld(unsigned* p)              { return __hip_atomic_load(p, __ATOMIC_RELAXED, __HIP_MEMORY_SCOPE_AGENT); }
__device__ __forceinline__ unsigned xb_add(unsigned* p, unsigned v) { return __hip_atomic_fetch_add(p, v, __ATOMIC_RELAXED, __HIP_MEMORY_SCOPE_AGENT); }
__device__ __forceinline__ unsigned xb_xcc_id() { return (unsigned)__builtin_amdgcn_s_getreg((3 << 11) | 20) & 0xFu; }
#define XB_SPIN(cond, bar) do { unsigned _sp = 0; while (cond) { __builtin_amdgcn_s_sleep(1); \
    if ((++_sp & 255u) == 0u) { if (xb_ld(&(bar)[XB_TMO])) break; if (_sp > XB_SPIN_CAP) { atomicAdd(&(bar)[XB_TMO], 1u); break; } } } } while (0)

struct XcdBarrier {
    unsigned* bar; unsigned x;
    volatile LAS unsigned* st;
};

__device__ __forceinline__ XcdBarrier xcd_barrier_post(unsigned* bar, volatile LAS unsigned* st) {
    XcdBarrier b; b.bar = bar; b.x = xb_xcc_id(); b.st = st;
    if (threadIdx.x == 0) (void)xb_add(&bar[XB_XCNT(b.x)], 1u);
    return b;
}
__device__ __forceinline__ void xcd_barrier_complete(unsigned* bar, unsigned x, unsigned& nloc, unsigned& nx) {
    const unsigned G = gridDim.x * gridDim.y * gridDim.z;
    unsigned sum, cnt, mine, sp = 0u;
    for (;;) {
        sum = 0u; cnt = 0u; mine = 0u;
#pragma unroll
        for (unsigned j = 0; j < 16; ++j) { const unsigned c = xb_ld(&bar[XB_XCNT(j)]); sum += c; cnt += (c > 0u) ? 1u : 0u; mine = (j == x) ? c : mine; }
        if (sum == G) break;
        __builtin_amdgcn_s_sleep(1);
        if ((++sp & 255u) == 0u) { if (xb_ld(&bar[XB_TMO])) break; if (sp > XB_SPIN_CAP) { atomicAdd(&bar[XB_TMO], 1u); break; } }
    }
    nloc = mine > 0u ? mine : 1u; nx = cnt > 0u ? cnt : 1u;
}

__device__ __forceinline__ void xcd_barrier(const XcdBarrier& b) {
    asm volatile("s_waitcnt vmcnt(0)" ::: "memory");
    __syncthreads();
    if (threadIdx.x == 0) {
        unsigned* bar = b.bar;
        __builtin_amdgcn_s_waitcnt(0);
        unsigned nloc = b.st[0], nx = b.st[1];
        if (nloc == 0u) { xcd_barrier_complete(bar, b.x, nloc, nx); b.st[0] = nloc; b.st[1] = nx; }
        const unsigned old = xb_add(&bar[XB_XSUB(b.x)], 1u);
        const unsigned gen = old / nloc;
        if (old + 1u == (gen + 1u) * nloc) {
            __builtin_amdgcn_fence(__ATOMIC_RELEASE, "agent");
            asm volatile("s_waitcnt vmcnt(0)" ::: "memory");
            const unsigned og = xb_add(&bar[XB_TOP], 1u);
            const unsigned tg = og / nx;
            if (og + 1u == (tg + 1u) * nx) xb_add(&bar[XB_TOPGEN], 1u);
            else XB_SPIN(xb_ld(&bar[XB_TOPGEN]) == tg, bar);
            __builtin_amdgcn_fence(__ATOMIC_ACQUIRE, "agent");
            xb_add(&bar[XB_XGEN(b.x)], 1u);
            asm volatile("s_waitcnt vmcnt(0)" ::: "memory");
        } else {
            XB_SPIN(xb_ld(&bar[XB_XGEN(b.x)]) == gen, bar);
            __builtin_amdgcn_fence(__ATOMIC_ACQUIRE, "agent");
            asm volatile("s_waitcnt vmcnt(0)" ::: "memory");
        }
    }
    __syncthreads();
}

template <int MODE>
__device__ __forceinline__ void run_gemm(LAS unsigned char* lds, const bf16_t* A, const bf16_t* Bt, int M, int N, int K, const Params& P) {
    pg8::Gemm g{A, Bt, M, N, K}; pg8::StaticOrder S; S.init(M, N, (int)gridDim.x, (int)blockIdx.x);
    EpiAll<MODE> E; E.ws = P.ws; E.x = P.in[0]; E.out = P.out;
    pg8::gemm_phase<EpiAll<MODE>, pg8::StaticOrder, true, true>(lds, g, S, E);
}

#ifndef REP_HA
#define REP_HA 1
#endif
#ifndef REP_HB
#define REP_HB 1
#endif
#ifndef REP_RA
#define REP_RA 1
#endif
#ifndef REP_RB
#define REP_RB 1
#endif
#ifndef REP_R1
#define REP_R1 1
#endif
#ifndef REP_SMALL
#define REP_SMALL 1
#endif
#ifndef DRY_HB
#define DRY_HB 0
#endif
#ifndef REP_GU
#define REP_GU 1
#endif
#ifdef PROBE_TS
#define TSTAMP(k) do { if (blockIdx.x == 0 && threadIdx.x == 0) ((volatile unsigned long long*)(ws + WS_END))[k] = __builtin_amdgcn_s_memrealtime(); } while (0)
#else
#define TSTAMP(k) do {} while (0)
#endif
#ifdef USE_CG_SYNC
#define GRID_BAR() grid.sync()
#else
#define GRID_BAR() do { XcdBarrier b_; b_.bar = (unsigned*)(P.ws + WS_BAR); b_.x = xb_xcc_id(); b_.st = (volatile LAS unsigned*)(lds + 4 * 36864); xcd_barrier(b_); } while (0)
#endif
__global__ void __launch_bounds__(NTHREADS, 2) mk_fwd(Params P) {
    extern __shared__ __attribute__((aligned(16))) unsigned char lds_raw[];
    LAS unsigned char* lds = (LAS unsigned char*)lds_raw;
    cg::grid_group grid = cg::this_grid();
    unsigned char* ws = P.ws;
    volatile LAS unsigned* MISC = (volatile LAS unsigned*)(lds + 4 * 36864);
    if (threadIdx.x < 2) MISC[threadIdx.x] = 0u;
    __syncthreads();
    (void)xcd_barrier_post((unsigned*)(ws + WS_BAR), MISC);
    bf16_t* W_R12 = (bf16_t*)(ws + WS_W_R12); bf16_t* HX = (bf16_t*)(ws + WS_HX); bf16_t* YA = (bf16_t*)(ws + WS_YA); bf16_t* SCR = (bf16_t*)(ws + WS_SCR);

    TSTAMP(0);
    for (int rep_ = 0; rep_ < REP_SMALL; ++rep_) { p0_phase(P, lds); GRID_BAR(); }
    if (P.ws == nullptr) grid.sync();
    TSTAMP(1);
    for (int rep_ = 0; rep_ < REP_SMALL; ++rep_) { norm_mod_phase(P.in[0], P.in[2], MT, HX, P.in[6], (const float*)(ws + WS_MODP), 8, P.in[5], 0, 1024, lds); __syncthreads(); }
    {
        float* modf_ = (float*)(ws + WS_MODF); const float* modp = (const float*)(ws + WS_MODP);
        const int idx = blockIdx.x * NTHREADS + threadIdx.x;
        for (int i = idx; i < 3 * 6144; i += gridDim.x * NTHREADS) { const int r = i / 6144, jx = i % 6144; float s = P.in[5][jx];
            for (int p = 0; p < 8; ++p) s += modp[(size_t)(p * 3 + r) * 6144 + jx];
            modf_[i] = s; }
    }
    GRID_BAR(); TSTAMP(2);
    for (int rep_ = 0; rep_ < REP_R1; ++rep_) { run_gemm<1>(lds, HX, W_R12, MT, 4096, 1024, P); GRID_BAR(); } TSTAMP(3);
    for (int rep_ = 0; rep_ < REP_HA; ++rep_) { scan_phase<0, 0>(P, lds); GRID_BAR(); } TSTAMP(4);
    fold_phase<0>(P); GRID_BAR();
    for (int rep_ = 0; rep_ < REP_HB; ++rep_) { scan_phase<0, 1>(P, lds); GRID_BAR(); } TSTAMP(5);
    for (int rep_ = 0; rep_ < REP_SMALL; ++rep_) norm_h_phase(P.out, P.in[11], YA);
    GRID_BAR(); TSTAMP(6);
    run_gemm<2>(lds, HX, W_R12 + (size_t)4096 * 1024, MT, 4096, 1024, P);
    GRID_BAR(); TSTAMP(7);
    for (int rep_ = 0; rep_ < REP_RA; ++rep_) { scan_phase<1, 0>(P, lds); GRID_BAR(); } TSTAMP(8);
    fold_phase<1>(P); GRID_BAR();
    for (int rep_ = 0; rep_ < REP_RB; ++rep_) { scan_phase<1, 1>(P, lds); GRID_BAR(); } TSTAMP(9);
    for (int rep_ = 0; rep_ < REP_SMALL; ++rep_) { norm_r_phase((const bf16_t*)P.out, SCR); p0b_phase(P, lds); }
    GRID_BAR(); TSTAMP(10);
    run_gemm<3>(lds, HX, (const bf16_t*)(ws + WS_W_R3), MX, 5120, 1024, P);
    GRID_BAR(); TSTAMP(11);
    run_gemm<4>(lds, YA, (const bf16_t*)(ws + WS_W_PA), MX, 1024, 1024, P);
    run_gemm<5>(lds, SCR, (const bf16_t*)(ws + WS_W_PB), MX, 1024, 2048, P);
    GRID_BAR(); TSTAMP(12);
    run_gemm<6>(lds, HX, (const bf16_t*)(ws + WS_W_OUT), MX, 1024, 1024, P);
    GRID_BAR(); TSTAMP(13);
    for (int rep_ = 0; rep_ < REP_SMALL; ++rep_) { norm_mod_phase(P.out, nullptr, MX, YA, P.in[7], (const float*)(ws + WS_MODF), 1, nullptr, 3072, 4096, lds); __syncthreads(); }
    GRID_BAR(); TSTAMP(14);
    for (int rep_ = 0; rep_ < REP_GU; ++rep_) { run_gemm<7>(lds, YA, (const bf16_t*)(ws + WS_W_GU), MX, 5632, 1024, P); GRID_BAR(); } TSTAMP(15);
    run_gemm<8>(lds, SCR, (const bf16_t*)(ws + WS_W_DN), MX, 1024, DFF, P);
    GRID_BAR(); TSTAMP(16);
#ifdef REP_SYNC
    for (int rep_ = 0; rep_ < REP_SYNC; ++rep_) GRID_BAR();
#endif
    final_norm_phase(P.out, P.in[20]);
#ifdef PROBE_TS
    GRID_BAR(); TSTAMP(17);
    if (blockIdx.x == 0 && threadIdx.x == 0) { volatile unsigned long long* ts = (volatile unsigned long long*)(ws + WS_END);
        const float T1 = (float)(ts[PROBE_A1] - ts[PROBE_A0]) * 0.01f, T2 = (float)(ts[PROBE_B1] - ts[PROBE_B0]) * 0.01f;
        P.out[0] = T1; for (int i = 0; i < 10000; ++i) P.out[1024 + i] = T2; }
#endif
}

extern "C" void kernel_launch(void* const* d_in, const int* in_sizes, int n_in, void* d_out, int out_size, void* d_ws, size_t ws_size, hipStream_t stream) {
    static int grid_blocks = 0;
    if (grid_blocks == 0) {
        if (n_in != 21 || ws_size < WS_BAR + XCD_BAR_WORDS * 4) { fprintf(stderr, "kernel_launch: unexpected n_in %d / ws_size %zu (need %zu)\n", n_in, ws_size, (size_t)WS_END); grid_blocks = -1; return; }
        int dev = 0, cus = 0, per_cu = 0;
        hipGetDevice(&dev);
        hipDeviceGetAttribute(&cus, hipDeviceAttributeMultiprocessorCount, dev);
        hipFuncSetAttribute((const void*)mk_fwd, hipFuncAttributeMaxDynamicSharedMemorySize, LDS_BYTES);
        hipOccupancyMaxActiveBlocksPerMultiprocessor(&per_cu, (const void*)mk_fwd, NTHREADS, LDS_BYTES);
        if (per_cu < 1) per_cu = 1;
        grid_blocks = cus * per_cu;
        (void)hipGetLastError();
    }
    if (grid_blocks < 0) return;
    (void)hipMemsetAsync((unsigned char*)d_ws + WS_BAR, 0, XCD_BAR_WORDS * 4, stream);
    Params p{};
    for (int i = 0; i < 21; ++i) p.in[i] = (const float*)d_in[i];
    p.out = (float*)d_out; p.ws = (unsigned char*)d_ws;
    void* args[] = {&p};
    hipError_t e = hipLaunchCooperativeKernel((const void*)mk_fwd, dim3(grid_blocks), dim3(NTHREADS), args, LDS_BYTES, stream);
    if (e != hipSuccess) fprintf(stderr, "cooperative launch failed: %s (grid %d)\n", hipGetErrorString(e), grid_blocks);
}
```

```cpp
#include <hip/hip_runtime.h>
#include <hip/hip_cooperative_groups.h>
#include <cstdio>
#include <cstdint>
namespace cg = cooperative_groups;
namespace pg8 {
#define PG8_LAS __attribute__((address_space(3)))
typedef unsigned short bf16_t;
typedef short bf16x8 __attribute__((ext_vector_type(8)));
typedef float f32x4 __attribute__((ext_vector_type(4)));
typedef unsigned u32x4 __attribute__((ext_vector_type(4)));
constexpr int BM = 256, BK = 64, HALF = 128, HTB = HALF * BK * 2  , STAGE_BYTES = 8 * HTB, NXCD = 8, WGM = 8;

__host__ __device__ __forceinline__ int lds_byte(int r, int c) { const int st = (r >> 4) * 2 + (c >> 5), rr = r & 15, cc = c & 31, ob = rr * 64 + cc * 2; return st * 1024 + (ob ^ (((ob >> 9) & 1) << 5)); }
__host__ __device__ __forceinline__ void stage_rc(int b, int& R, int& C) { const int st = b / 1024, sb = b % 1024, swz = sb ^ (((sb >> 9) & 1) << 5); R = (st >> 1) * 16 + swz / 64; C = (st & 1) * 32 + (swz % 64) / 2; }
__host__ __device__ __forceinline__ int perm32(int rho) { const int n = rho >> 4, i = rho & 15; return 8 * (i >> 2) + 4 * n + (i & 3); }

struct Unit { int pm, pn; };
struct Gemm { const bf16_t* A; const bf16_t* Bt; int M, N, K; };

struct StaticOrder {
    int nM, nN, nwg, G, c;
    __host__ __device__ void init(int M, int N, int G_, int c_) { nM = M / BM; nN = N / BM; nwg = nM * nN; G = G_; c = c_; }
    __host__ __device__ bool next(int i, Unit& u) const {
        const long L = (long)i * G + c; if (L >= nwg) return false;
        int wgid = (int)L; { const int q = nwg / NXCD, r = nwg % NXCD, xcd = wgid % NXCD, off = wgid / NXCD; wgid = (xcd < r ? xcd * (q + 1) : r * (q + 1) + (xcd - r) * q) + off; }
        const int nig = WGM * nN, gid = wgid / nig, fm = gid * WGM, gsz = (nM - fm) < WGM ? (nM - fm) : WGM;
        u.pm = fm + ((wgid % nig) % gsz); u.pn = (wgid % nig) / gsz; return true;
    }
    __device__ __forceinline__ void a_ready(const Unit&) const {}
    __device__ __forceinline__ void done(const Unit&) const {}
};

__device__ __forceinline__ unsigned cvt_pk_bf16(float lo, float hi) { unsigned r; asm volatile("v_cvt_pk_bf16_f32 %0, %1, %2" : "=v"(r) : "v"(lo), "v"(hi)); return r; }
typedef float f32x2 __attribute__((ext_vector_type(2)));
template <class Epi, class Sched, bool ALIGN_EPI = false, bool SP2 = false>
__device__ __forceinline__ void gemm_phase(PG8_LAS unsigned char* lds, const Gemm g, const Sched& S, const Epi& E) {
    int tid_l = threadIdx.x; asm volatile("" : "+v"(tid_l));
    const int tid = tid_l, wid = __builtin_amdgcn_readfirstlane(tid >> 6), lane = tid & 63, wr = wid >> 2, wc = wid & 3, fr = lane & 15, fq = lane >> 4;
    const int K = g.K, nt = K / BK;
    unsigned voffA[2], voffB[2];
#pragma unroll
    for (int i = 0; i < 2; ++i) { int R, C; stage_rc(tid * 16 + i * 8192, R, C); const int Rb = Epi::PERM ? ((R & ~31) + perm32(R & 31)) : R;
        voffA[i] = (unsigned)(R * K + C) * 2u; voffB[i] = (unsigned)(Rb * K + C) * 2u; }
    const size_t kstep = (size_t)(BK * 2);
    const size_t hstep = (size_t)HALF * K * 2;
    const size_t tstep = 2 * hstep;
    const unsigned ldsw = (unsigned)wid * 1024u;
    const int aoff = lds_byte(wr * 64 + fr, fq * 8), boff = lds_byte(wc * 32 + fr, fq * 8);
#define PG8_SA(b, h) (((b) * 2 + (h)) * HTB)
#define PG8_SB(b, h) ((4 + (b) * 2 + (h)) * HTB)
#define PG8_STAGE(bufoff, gbase, voff) do { _Pragma("unroll") for (int _i = 0; _i < 2; ++_i) \
        __builtin_amdgcn_global_load_lds((const unsigned*)((const char*)(gbase) + (voff)[_i]), (PG8_LAS unsigned*)(lds + (bufoff) + ldsw + _i * 8192), 16, 0, 0); } while (0)
#define PG8_LDA(dst, b, h) do { _Pragma("unroll") for (int m = 0; m < 4; ++m) _Pragma("unroll") for (int k = 0; k < 2; ++k) dst[m][k] = *(const PG8_LAS bf16x8*)(lds + PG8_SA(b, h) + aoff + m * 2048 + k * 1024); } while (0)
#define PG8_LDB(dst, b, h) do { _Pragma("unroll") for (int n = 0; n < 2; ++n) _Pragma("unroll") for (int k = 0; k < 2; ++k) dst[n][k] = *(const PG8_LAS bf16x8*)(lds + PG8_SB(b, h) + boff + n * 2048 + k * 1024); } while (0)
#define PG8_MMA(ai, bj, At, Bt) do { __builtin_amdgcn_s_setprio(1); _Pragma("unroll") for (int m = 0; m < 4; ++m) _Pragma("unroll") for (int n = 0; n < 2; ++n) _Pragma("unroll") for (int k = 0; k < 2; ++k) \
        acc[ai][bj][m][n] = __builtin_amdgcn_mfma_f32_16x16x32_bf16(Bt[n][k], At[m][k], acc[ai][bj][m][n], 0, 0, 0); __builtin_amdgcn_s_setprio(0); } while (0)
#define PG8_WAIT_V(n) asm volatile("s_waitcnt vmcnt(" #n ")" ::: "memory")
#define PG8_WAIT_L(n) asm volatile("s_waitcnt lgkmcnt(" #n ")" ::: "memory")
#define PG8_BAR __builtin_amdgcn_s_barrier()
#define PG8_SCHED __builtin_amdgcn_sched_barrier(0)
    Unit cur, nxt; int ui = 0;
    if (!S.next(0, cur)) return;
    f32x4 acc[2][2][4][2];
#pragma unroll
    for (int a = 0; a < 2; ++a)
#pragma unroll
        for (int b = 0; b < 2; ++b)
#pragma unroll
            for (int m = 0; m < 4; ++m)
#pragma unroll
                for (int n = 0; n < 2; ++n) acc[a][b][m][n] = (f32x4){0.f, 0.f, 0.f, 0.f};
    bf16x8 At[4][2], B0[2][2], B1[2][2];
    const char* cA = (const char*)g.A + (size_t)cur.pm * tstep; const char* cB = (const char*)g.Bt + (size_t)cur.pn * tstep;
    S.a_ready(cur);
    if constexpr (SP2) {
        PG8_STAGE(PG8_SB(0, 0), cB, voffB); PG8_STAGE(PG8_SB(0, 1), cB + hstep, voffB); PG8_STAGE(PG8_SA(0, 0), cA, voffA); PG8_STAGE(PG8_SA(0, 1), cA + hstep, voffA);
        if (wr == 1) PG8_BAR;
        PG8_WAIT_V(2); PG8_BAR;
        PG8_STAGE(PG8_SB(1, 0), cB + kstep, voffB); PG8_STAGE(PG8_SA(1, 0), cA + kstep, voffA); PG8_STAGE(PG8_SB(1, 1), cB + hstep + kstep, voffB);
        PG8_WAIT_V(6); PG8_BAR;
    } else {
        PG8_STAGE(PG8_SB(0, 0), cB, voffB); PG8_STAGE(PG8_SA(0, 0), cA, voffA); PG8_STAGE(PG8_SB(0, 1), cB + hstep, voffB); PG8_STAGE(PG8_SA(0, 1), cA + hstep, voffA);
        if (wr == 1) PG8_BAR;
        PG8_WAIT_V(4); PG8_BAR;
        PG8_STAGE(PG8_SB(1, 0), cB + kstep, voffB); PG8_STAGE(PG8_SA(1, 0), cA + kstep, voffA); PG8_STAGE(PG8_SB(1, 1), cB + hstep + kstep, voffB);
        PG8_WAIT_V(6); PG8_BAR;
    }
    for (;;) {
        const bool has_next = S.next(ui + 1, nxt);
        const char* nA = has_next ? (const char*)g.A + (size_t)nxt.pm * tstep : cA; const char* nB = has_next ? (const char*)g.Bt + (size_t)nxt.pn * tstep : cB;
        for (int t = 0; t < nt; t += 2) {
            const bool last = (t == nt - 2);
            const char* a1 = cA + (size_t)(t + 1) * kstep;
            const char* a2 = last ? nA : cA + (size_t)(t + 2) * kstep; const char* b2 = last ? nB : cB + (size_t)(t + 2) * kstep;
            const char* a3 = a2 + kstep; const char* b3 = b2 + kstep;
            if (last && has_next) S.a_ready(nxt);
            if constexpr (SP2) {
            PG8_LDB(B0, 0, 0); PG8_LDB(B1, 0, 1); PG8_SCHED; PG8_LDA(At, 0, 0); PG8_STAGE(PG8_SA(1, 1), a1 + hstep, voffA);
            PG8_WAIT_V(8); PG8_WAIT_L(0); PG8_BAR; PG8_MMA(0, 0, At, B0); PG8_MMA(0, 1, At, B1); PG8_BAR; PG8_SCHED;
            PG8_LDA(At, 0, 1); PG8_STAGE(PG8_SB(0, 0), b2, voffB); PG8_STAGE(PG8_SB(0, 1), b2 + hstep, voffB); PG8_STAGE(PG8_SA(0, 0), a2, voffA);
            PG8_WAIT_V(8); PG8_WAIT_L(0); PG8_BAR; PG8_MMA(1, 0, At, B0); PG8_MMA(1, 1, At, B1); PG8_BAR; PG8_SCHED;
            PG8_LDB(B0, 1, 0); PG8_LDB(B1, 1, 1); PG8_SCHED; PG8_LDA(At, 1, 0); PG8_STAGE(PG8_SA(0, 1), a2 + hstep, voffA);
            PG8_WAIT_V(8); PG8_WAIT_L(0); PG8_BAR; PG8_MMA(0, 0, At, B0); PG8_MMA(0, 1, At, B1); PG8_BAR; PG8_SCHED;
            PG8_LDA(At, 1, 1); PG8_STAGE(PG8_SB(1, 0), b3, voffB); PG8_STAGE(PG8_SB(1, 1), b3 + hstep, voffB); PG8_STAGE(PG8_SA(1, 0), a3, voffA);
            PG8_WAIT_V(8); PG8_WAIT_L(0); PG8_BAR; PG8_MMA(1, 0, At, B0); PG8_MMA(1, 1, At, B1); PG8_BAR; PG8_SCHED;
            } else {
            PG8_LDB(B0, 0, 0); PG8_SCHED; PG8_LDA(At, 0, 0); PG8_STAGE(PG8_SA(1, 1), a1 + hstep, voffA);
            PG8_WAIT_L(8); PG8_BAR; PG8_WAIT_L(0); PG8_MMA(0, 0, At, B0); PG8_BAR; PG8_SCHED;
            PG8_LDB(B1, 0, 1); PG8_STAGE(PG8_SB(0, 0), b2, voffB);
            PG8_BAR; PG8_WAIT_L(0); PG8_MMA(0, 1, At, B1); PG8_BAR;
            PG8_LDA(At, 0, 1); PG8_STAGE(PG8_SA(0, 0), a2, voffA);
            PG8_BAR; PG8_WAIT_L(0); PG8_MMA(1, 0, At, B0); PG8_BAR; PG8_SCHED;
            PG8_STAGE(PG8_SB(0, 1), b2 + hstep, voffB);
            PG8_WAIT_V(6); PG8_BAR; PG8_MMA(1, 1, At, B1); PG8_BAR;
            PG8_LDB(B0, 1, 0); PG8_SCHED; PG8_LDA(At, 1, 0); PG8_STAGE(PG8_SA(0, 1), a2 + hstep, voffA);
            PG8_WAIT_L(8); PG8_BAR; PG8_WAIT_L(0); PG8_MMA(0, 0, At, B0); PG8_BAR; PG8_SCHED;
            PG8_LDB(B1, 1, 1); PG8_STAGE(PG8_SB(1, 0), b3, voffB);
            PG8_BAR; PG8_WAIT_L(0); PG8_MMA(0, 1, At, B1); PG8_BAR;
            PG8_LDA(At, 1, 1); PG8_STAGE(PG8_SA(1, 0), a3, voffA);
            PG8_BAR; PG8_WAIT_L(0); PG8_MMA(1, 0, At, B0); PG8_BAR; PG8_SCHED;
            PG8_STAGE(PG8_SB(1, 1), b3 + hstep, voffB);
            PG8_WAIT_V(6); PG8_BAR; PG8_MMA(1, 1, At, B1); PG8_BAR;
            }
        }
        if constexpr (ALIGN_EPI) { if (wr == 0) PG8_BAR; }
        if constexpr (!Epi::AFTER_DRAIN) { E(acc, cur, wr, wc, fr, fq); S.done(cur); }
        if (!has_next) break;
#pragma unroll
        for (int a = 0; a < 2; ++a)
#pragma unroll
            for (int b = 0; b < 2; ++b)
#pragma unroll
                for (int m = 0; m < 4; ++m)
#pragma unroll
                    for (int n = 0; n < 2; ++n) acc[a][b][m][n] = (f32x4){0.f, 0.f, 0.f, 0.f};
        cur = nxt; cA = nA; cB = nB; ++ui;
        if constexpr (ALIGN_EPI) { if (wr == 1) PG8_BAR; }
    }
    PG8_WAIT_V(0);
    if constexpr (!ALIGN_EPI) { if (wr == 0) PG8_BAR; }
    PG8_BAR;
    if constexpr (Epi::AFTER_DRAIN) { E.fused(acc, cur, wr, wc, fr, fq, lds, wid, lane); S.done(cur); }
#undef PG8_SA
#undef PG8_SB
#undef PG8_STAGE
#undef PG8_LDA
#undef PG8_LDB
#undef PG8_MMA
#undef PG8_WAIT_V
#undef PG8_WAIT_L
#undef PG8_BAR
#undef PG8_SCHED
}
}

#define LAS __attribute__((address_space(3)))
typedef unsigned short bf16_t;
typedef short bf16x8 __attribute__((ext_vector_type(8)));
typedef short s16x4 __attribute__((ext_vector_type(4)));
typedef float f32x4 __attribute__((ext_vector_type(4)));
typedef float f32x2 __attribute__((ext_vector_type(2)));
typedef float f32x16 __attribute__((ext_vector_type(16)));
typedef unsigned u32x4 __attribute__((ext_vector_type(4)));
typedef unsigned u32x2 __attribute__((ext_vector_type(2)));
typedef __bf16 bf16x2_t __attribute__((ext_vector_type(2)));
typedef _Float16 f16x2_t __attribute__((ext_vector_type(2)));

constexpr int DM = 1024, NBATCH = 2, SEQ = 8192, CTXL = 256;
constexpr int MX = NBATCH * SEQ;
constexpr int MC = NBATCH * CTXL;
constexpr int MT = MX + MC;
constexpr int DFF = 2816;
constexpr int NTHREADS = 512, NWAVES = 8;
constexpr int LDS_BYTES = 4 * 36864 + 1024;

constexpr size_t SLOT_ELEMS = (size_t)MT * 1024;
constexpr size_t WS_W_R12 = 0;
constexpr size_t WS_W_GU  = WS_W_R12 + (size_t)8192 * 1024 * 2;
constexpr size_t WS_W_DN  = WS_W_GU  + (size_t)5632 * 1024 * 2;
constexpr size_t WS_W_R3  = WS_W_DN  + (size_t)1024 * 2816 * 2;
constexpr size_t WS_W_PA  = WS_W_R3  + (size_t)5120 * 1024 * 2;
constexpr size_t WS_W_PB  = WS_W_PA  + (size_t)1024 * 1024 * 2;
constexpr size_t WS_W_OUT = WS_W_PB  + (size_t)1024 * 2048 * 2;
constexpr size_t WS_HX    = WS_W_OUT + (size_t)1024 * 1024 * 2;
constexpr size_t WS_YA    = WS_HX    + SLOT_ELEMS * 2;
constexpr size_t WS_SCR   = WS_YA    + (size_t)MX * 1024 * 2;
constexpr size_t WS_MODP  = WS_SCR   + 4 * SLOT_ELEMS * 2;
constexpr size_t WS_MODF  = WS_MODP  + (size_t)8 * 3 * 6144 * 4;
constexpr size_t WS_LBV   = WS_MODF  + (size_t)3 * 6144 * 4;
constexpr size_t WS_ROPE  = WS_LBV   + (size_t)2 * 1024 * 4;
constexpr size_t WS_CSH   = WS_ROPE  + (size_t)(4096 + 4096 + 2048 + 2048) * 4;
constexpr size_t WS_CSR   = WS_CSH   + (size_t)2 * 2 * 8 * 128 * 128 * 4;
constexpr size_t WS_GSUM  = WS_CSR   + (size_t)2 * 2 * 8 * 128 * 256 * 4;
constexpr size_t WS_END   = WS_GSUM  + (size_t)16 * 2 * 16 * 128 * 4;
constexpr size_t WS_BAR   = WS_END + 1024;
static_assert(WS_W_R3 - WS_W_R12 >= (size_t)32 * 2 * 8 * 16384 * 4, "retention segment states must fit");

struct Params { const float* in[21]; float* out; unsigned char* ws; };

__device__ __forceinline__ unsigned pkbf(float lo, float hi) { f32x2 v = {lo, hi}; bf16x2_t b = __builtin_convertvector(v, bf16x2_t); return __builtin_bit_cast(unsigned, b); }
__device__ __forceinline__ unsigned pkf16(float lo, float hi) { f32x2 v = {lo, hi}; f16x2_t b = __builtin_convertvector(v, f16x2_t); return __builtin_bit_cast(unsigned, b); }
__device__ __forceinline__ float bf2f(unsigned short u) { return __builtin_bit_cast(float, (unsigned)u << 16); }
__device__ __forceinline__ float bflo(unsigned u) { return __builtin_bit_cast(float, u << 16); }
__device__ __forceinline__ float bfhi(unsigned u) { return __builtin_bit_cast(float, u & 0xffff0000u); }
__device__ __forceinline__ float f16tof(unsigned short u) { return (float)__builtin_bit_cast(_Float16, u); }
__device__ __forceinline__ float sigmoidf_(float z) { return __builtin_amdgcn_rcpf(1.0f + __expf(-z)); }
__device__ __forceinline__ float siluf_(float z) { return z * sigmoidf_(z); }
__device__ __forceinline__ float wave_sum(float v) {
#pragma unroll
    for (int o = 1; o < 64; o <<= 1) v += __shfl_xor(v, o);
    return v;
}
#define LDS_WAIT() asm volatile("s_waitcnt lgkmcnt(0)" ::: "memory")

template <int mode> struct EpiAll {
    static constexpr bool PERM = true, AFTER_DRAIN = false;
    unsigned char* ws; const float* x; float* out;
    __device__ __forceinline__ void store8(bf16_t* p, const f32x4& a, const f32x4& b) const {
        u32x4 w; w.x = pkbf(a[0], a[1]); w.y = pkbf(a[2], a[3]); w.z = pkbf(b[0], b[1]); w.w = pkbf(b[2], b[3]); *(u32x4*)p = w;
    }
    __device__ __forceinline__ void operator()(const f32x4 (&acc)[2][2][4][2], const pg8::Unit& u, int wr, int wc, int fr, int fq) const {
        const int row0 = u.pm * 256 + wr * 64 + fr;
        const int cin = wc * 32 + 8 * fq;
        bf16_t* SCR = (bf16_t*)(ws + WS_SCR);
        if (mode == 1) {
            const int seg = u.pn >> 2, col0 = (u.pn & 3) * 256 + cin;
            bf16_t* base = SCR + (size_t)seg * SLOT_ELEMS;
            if (seg == 1 || seg == 2) {
                const float* lbv = (const float*)(ws + WS_LBV) + (seg - 1) * 1024;
#pragma unroll
                for (int bj = 0; bj < 2; ++bj) {
                    const f32x4 l0 = *(const f32x4*)(lbv + col0 + bj * 128), l1 = *(const f32x4*)(lbv + col0 + bj * 128 + 4);
#pragma unroll
                    for (int ai = 0; ai < 2; ++ai)
#pragma unroll
                        for (int m = 0; m < 4; ++m) {
                            float v[8];
#pragma unroll
                            for (int j = 0; j < 4; ++j) {
                                const float z0 = acc[ai][bj][m][0][j], z1 = acc[ai][bj][m][1][j];
                                v[j] = __logf(l0[j] + (1.0f - l0[j]) * sigmoidf_(z0));
                                v[4 + j] = __logf(l1[j] + (1.0f - l1[j]) * sigmoidf_(z1));
                            }
                            u32x4 w; w.x = pkf16(v[0], v[1]); w.y = pkf16(v[2], v[3]); w.z = pkf16(v[4], v[5]); w.w = pkf16(v[6], v[7]);
                            *(u32x4*)(base + (size_t)(row0 + ai * 128 + m * 16) * 1024 + col0 + bj * 128) = w;
                        }
                }
            } else {
                const float sc = seg == 0 ? 0.08838834764831845f : 1.0f;
#pragma unroll
                for (int ai = 0; ai < 2; ++ai)
#pragma unroll
                    for (int m = 0; m < 4; ++m)
#pragma unroll
                        for (int bj = 0; bj < 2; ++bj)
                            store8(base + (size_t)(row0 + ai * 128 + m * 16) * 1024 + col0 + bj * 128, acc[ai][bj][m][0] * sc, acc[ai][bj][m][1] * sc);
            }
        } else if (mode == 2) {
            if (u.pn < 8) {
                const int seg = u.pn >> 2, tile = u.pn & 3;
                bf16_t* base = SCR + (size_t)seg * SLOT_ELEMS;
                const float sc = seg == 0 ? 0.08838834764831845f : 1.0f;
                const int head = 2 * tile + (cin >> 6), e = cin & 63;
                const float* rp = (const float*)(ws + WS_ROPE);
                const bool latent = u.pm < 64;
#pragma unroll
                for (int ai = 0; ai < 2; ++ai)
#pragma unroll
                    for (int m = 0; m < 4; ++m) {
                        const int row = row0 + ai * 128 + m * 16;
                        f32x4 c0 = {1.f, 1.f, 1.f, 1.f}, c1 = c0, s0 = {0.f, 0.f, 0.f, 0.f}, s1 = s0;
                        if (latent) {
                            const int pos = row & (SEQ - 1), prow = pos >> 6, pcol = pos & 63;
                            const float* cp = e < 32 ? rp + prow * 32 + e : rp + 8192 + pcol * 32 + (e - 32);
                            const float* sp = e < 32 ? rp + 4096 + prow * 32 + e : rp + 8192 + 2048 + pcol * 32 + (e - 32);
                            c0 = *(const f32x4*)cp; c1 = *(const f32x4*)(cp + 4); s0 = *(const f32x4*)sp; s1 = *(const f32x4*)(sp + 4);
                        }
                        const f32x4 a0 = acc[ai][0][m][0] * sc, a1 = acc[ai][0][m][1] * sc, b0 = acc[ai][1][m][0] * sc, b1 = acc[ai][1][m][1] * sc;
                        bf16_t* p = base + (size_t)row * 1024 + head * 128 + e;
                        store8(p, a0 * c0 - b0 * s0, a1 * c1 - b1 * s1);
                        store8(p + 64, a0 * s0 + b0 * c0, a1 * s1 + b1 * c1);
                        asm volatile("" ::: "memory");
                    }
            } else {
                bf16_t* base = SCR + 2 * SLOT_ELEMS;
                const int col0 = (u.pn - 8) * 256 + cin;
#pragma unroll
                for (int ai = 0; ai < 2; ++ai)
#pragma unroll
                    for (int m = 0; m < 4; ++m)
#pragma unroll
                        for (int bj = 0; bj < 2; ++bj)
                            store8(base + (size_t)(row0 + ai * 128 + m * 16) * 2048 + col0 + bj * 128, acc[ai][bj][m][0], acc[ai][bj][m][1]);
            }
        } else if (mode == 3) {
            bf16_t* p; int ld, col0; bool gate;
            if (u.pn < 4) { p = (bf16_t*)(ws + WS_YA); ld = 1024; col0 = u.pn * 256 + cin; gate = true; }
            else if (u.pn < 12) { p = SCR; ld = 2048; col0 = (u.pn - 4) * 256 + cin; gate = true; }
            else { const int s = (u.pn - 12) >> 2; p = SCR + (size_t)(2 + s) * SLOT_ELEMS; ld = 1024; col0 = ((u.pn - 12) & 3) * 256 + cin; gate = false; }
#pragma unroll
            for (int ai = 0; ai < 2; ++ai)
#pragma unroll
                for (int m = 0; m < 4; ++m)
#pragma unroll
                    for (int bj = 0; bj < 2; ++bj) {
                        bf16_t* q = p + (size_t)(row0 + ai * 128 + m * 16) * ld + col0 + bj * 128;
                        f32x4 v0 = acc[ai][bj][m][0], v1 = acc[ai][bj][m][1];
                        if (gate) {
                            const u32x4 y = *(const u32x4*)q;
                            v0[0] = siluf_(v0[0]) * bflo(y.x); v0[1] = siluf_(v0[1]) * bfhi(y.x); v0[2] = siluf_(v0[2]) * bflo(y.y); v0[3] = siluf_(v0[3]) * bfhi(y.y);
                            v1[0] = siluf_(v1[0]) * bflo(y.z); v1[1] = siluf_(v1[1]) * bfhi(y.z); v1[2] = siluf_(v1[2]) * bflo(y.w); v1[3] = siluf_(v1[3]) * bfhi(y.w);
                        } else {
#pragma unroll
                            for (int j = 0; j < 4; ++j) { v0[j] = sigmoidf_(v0[j]); v1[j] = sigmoidf_(v1[j]); }
                        }
                        store8(q, v0, v1);
                        asm volatile("" ::: "memory");
                    }
        } else if (mode == 4 || mode == 5) {
            const bf16_t* sg = SCR + (size_t)(mode == 4 ? 2 : 3) * SLOT_ELEMS;
            bf16_t* mg = (bf16_t*)(ws + WS_HX);
            const int col0 = u.pn * 256 + cin;
#pragma unroll
            for (int ai = 0; ai < 2; ++ai)
#pragma unroll
                for (int m = 0; m < 4; ++m)
#pragma unroll
                    for (int bj = 0; bj < 2; ++bj) {
                        const size_t off = (size_t)(row0 + ai * 128 + m * 16) * 1024 + col0 + bj * 128;
                        const u32x4 g = *(const u32x4*)(sg + off);
                        f32x4 v0 = acc[ai][bj][m][0], v1 = acc[ai][bj][m][1];
                        v0[0] *= bflo(g.x); v0[1] *= bfhi(g.x); v0[2] *= bflo(g.y); v0[3] *= bfhi(g.y);
                        v1[0] *= bflo(g.z); v1[1] *= bfhi(g.z); v1[2] *= bflo(g.w); v1[3] *= bfhi(g.w);
                        if (mode == 5) { const u32x4 tq = *(const u32x4*)(mg + off);
                            v0[0] += bflo(tq.x); v0[1] += bfhi(tq.x); v0[2] += bflo(tq.y); v0[3] += bfhi(tq.y); v1[0] += bflo(tq.z); v1[1] += bfhi(tq.z); v1[2] += bflo(tq.w); v1[3] += bfhi(tq.w); }
                        store8(mg + off, v0, v1);
                        asm volatile("" ::: "memory");
                    }
        } else if (mode == 6 || mode == 8) {
            const int col0 = u.pn * 256 + cin;
            const float* res = mode == 6 ? x : out;
            const float* gv = (const float*)(ws + WS_MODF) + (size_t)(u.pm >= 32 ? 1 : 0) * 6144 + (mode == 6 ? 2048 : 5120);
#pragma unroll
            for (int bj = 0; bj < 2; ++bj) {
                const f32x4 g0 = *(const f32x4*)(gv + col0 + bj * 128), g1 = *(const f32x4*)(gv + col0 + bj * 128 + 4);
#pragma unroll
                for (int ai = 0; ai < 2; ++ai)
#pragma unroll
                    for (int m = 0; m < 4; ++m) {
                        const size_t off = (size_t)(row0 + ai * 128 + m * 16) * 1024 + col0 + bj * 128;
                        const f32x4 r0 = *(const f32x4*)(res + off), r1 = *(const f32x4*)(res + off + 4);
                        *(f32x4*)(out + off) = r0 + g0 * acc[ai][bj][m][0];
                        *(f32x4*)(out + off + 4) = r1 + g1 * acc[ai][bj][m][1];
                        asm volatile("" ::: "memory");
                    }
            }
        } else {
            const int col0 = u.pn * 128 + cin;
#pragma unroll
            for (int ai = 0; ai < 2; ++ai)
#pragma unroll
                for (int m = 0; m < 4; ++m) {
                    f32x4 v0, v1;
#pragma unroll
                    for (int j = 0; j < 4; ++j) { v0[j] = siluf_(acc[ai][0][m][0][j]) * acc[ai][1][m][0][j]; v1[j] = siluf_(acc[ai][0][m][1][j]) * acc[ai][1][m][1][j]; }
                    store8(SCR + (size_t)(row0 + ai * 128 + m * 16) * DFF + col0, v0, v1);
                }
        }
    }
};

__device__ __forceinline__ void p0_transpose_item(const float* W, int K, int N, bf16_t* WT, int drow0, int k0, int n0, LAS float* scr, int lane) {
#pragma unroll 8
    for (int i = 0; i < 32; ++i) { const int kk = 2 * i + (lane >> 5); scr[kk * 33 + (lane & 31)] = W[(size_t)(k0 + kk) * N + n0 + (lane & 31)]; }
    LDS_WAIT(); asm volatile("" ::: "memory");
    const int c = lane & 7;
#pragma unroll
    for (int j = 0; j < 4; ++j) { const int n = (lane >> 3) + 8 * j; const LAS float* s = scr + (8 * c) * 33 + n;
        u32x4 o; o.x = pkbf(s[0 * 33], s[1 * 33]); o.y = pkbf(s[2 * 33], s[3 * 33]); o.z = pkbf(s[4 * 33], s[5 * 33]); o.w = pkbf(s[6 * 33], s[7 * 33]);
        *(u32x4*)(WT + (size_t)(drow0 + n) * K + k0 + 8 * c) = o; }
    LDS_WAIT(); asm volatile("" ::: "memory");
}
__device__ __forceinline__ int win_map(int c) {
    if (c < 4096) return c;
    if (c < 5120) return 8192 + (c - 4096);
    if (c < 7168) { const int seg = (c - 5120) >> 10, cc = (c - 5120) & 1023, head = cc >> 7, half = (cc >> 6) & 1, e = cc & 63;
        return 4096 + seg * 1024 + 256 * (head >> 1) + 128 * half + 64 * (head & 1) + e; }
    if (c < 9216) return c - 1024;
    return c;
}
__device__ __forceinline__ void p0_phase(const Params& P, LAS unsigned char* lds) {
    int tid_l = threadIdx.x; asm volatile("" : "+v"(tid_l)); const int tid = tid_l, lane = tid & 63, wave = tid >> 6, G = gridDim.x;
    unsigned char* ws = P.ws;
    LAS float* scr = (LAS float*)(lds + wave * 16384);
    const int gw = blockIdx.x * NWAVES + wave, NGW = G * NWAVES;
    constexpr int I0 = 16 * 416, I1 = 16 * 32, I2 = 32 * 32, I3 = 16 * 32, I4 = 16 * 88, I5 = 16 * 88, I6 = 44 * 32;
    constexpr int NITEMS = I0 + I1 + I2 + I3;
    for (int it = gw; it < NITEMS; it += NGW) {
        int r = it;
        if (r < I0) { const int kb = r / 416, nb = r % 416; const int dr = win_map(nb * 32);
            p0_transpose_item(P.in[8], 1024, 13312, dr < 8192 ? (bf16_t*)(ws + WS_W_R12) : (bf16_t*)(ws + WS_W_R3), dr < 8192 ? dr : dr - 8192, kb * 64, nb * 32, scr, lane); continue; } r -= I0;
        if (r < I1) { const int kb = r / 32, nb = r % 32; p0_transpose_item(P.in[14], 1024, 1024, (bf16_t*)(ws + WS_W_PA), nb * 32, kb * 64, nb * 32, scr, lane); continue; } r -= I1;
        if (r < I2) { const int kb = r / 32, nb = r % 32; p0_transpose_item(P.in[15], 2048, 1024, (bf16_t*)(ws + WS_W_PB), nb * 32, kb * 64, nb * 32, scr, lane); continue; } r -= I2;
        { const int kb = r / 32, nb = r % 32; p0_transpose_item(P.in[16], 1024, 1024, (bf16_t*)(ws + WS_W_OUT), nb * 32, kb * 64, nb * 32, scr, lane); }
    }
    __syncthreads();
    LAS float* sv = (LAS float*)lds;
    float* modp = (float*)(ws + WS_MODP);
    for (int item = blockIdx.x; item < 96; item += G) {
        const int ks = item / 12, cb = item % 12, col = cb * 512 + tid;
        if (tid < 384) { const int r = tid >> 7, kk = tid & 127; const float cv = r < 2 ? P.in[1][r * 1024 + ks * 128 + kk] : P.in[3][ks * 128 + kk]; sv[tid] = cv / (1.0f + expf(-cv)); }
        __syncthreads();
        float a0 = 0.f, a1 = 0.f, a2 = 0.f;
        const float* wp = P.in[4] + (size_t)(ks * 128) * 6144 + col;
#pragma unroll 8
        for (int kk = 0; kk < 128; ++kk) { const float w = wp[(size_t)kk * 6144]; a0 += sv[kk] * w; a1 += sv[128 + kk] * w; a2 += sv[256 + kk] * w; }
        modp[(size_t)(ks * 3 + 0) * 6144 + col] = a0; modp[(size_t)(ks * 3 + 1) * 6144 + col] = a1; modp[(size_t)(ks * 3 + 2) * 6144 + col] = a2;
        __syncthreads();
    }
    const int gt = blockIdx.x * NTHREADS + tid, NGT = G * NTHREADS;
    float* lbv = (float*)(ws + WS_LBV); float* rp = (float*)(ws + WS_ROPE);
    for (int i = gt; i < 2048; i += NGT) { const float* s = i < 1024 ? P.in[9] : P.in[10]; const int k = i & 1023; const float a0 = s[k], a1 = s[1024 + k]; lbv[i] = 1.0f / (1.0f + expf(a1 - a0)); }
    for (int i = gt; i < 4096 + 2048; i += NGT) {
        const bool isrow = i < 4096; const int ii = isrow ? i : i - 4096; const int p = ii >> 5, f = ii & 31;
        const float fr = powf(10000.0f, -(float)f / 32.0f); const float ang = (float)p * fr; float sn, cs; sincosf(ang, &sn, &cs);
        if (isrow) { rp[ii] = cs; rp[4096 + ii] = sn; } else { rp[8192 + ii] = cs; rp[8192 + 2048 + ii] = sn; }
    }
}

__device__ __forceinline__ void p0b_phase(const Params& P, LAS unsigned char* lds) {
    int tid_l = threadIdx.x; asm volatile("" : "+v"(tid_l)); const int tid = tid_l, lane = tid & 63, wave = tid >> 6, G = gridDim.x;
    unsigned char* ws = P.ws;
    LAS float* scr = (LAS float*)(lds + wave * 16384);
    const int gw = blockIdx.x * NWAVES + wave, NGW = G * NWAVES;
    constexpr int I4 = 16 * 88, I5 = 16 * 88, I6 = 44 * 32;
    for (int it = gw; it < I4 + I5 + I6; it += NGW) {
        int r = it;
        if (r < I4) { const int kb = r / 88, nb = r % 88, c = nb * 32; p0_transpose_item(P.in[17], 1024, DFF, (bf16_t*)(ws + WS_W_GU), 256 * (c >> 7) + (c & 127), kb * 64, c, scr, lane); continue; } r -= I4;
        if (r < I5) { const int kb = r / 88, nb = r % 88, c = nb * 32; p0_transpose_item(P.in[18], 1024, DFF, (bf16_t*)(ws + WS_W_GU), 256 * (c >> 7) + 128 + (c & 127), kb * 64, c, scr, lane); continue; } r -= I5;
        { const int kb = r / 32, nb = r % 32; p0_transpose_item(P.in[19], DFF, 1024, (bf16_t*)(ws + WS_W_DN), nb * 32, kb * 64, nb * 32, scr, lane); }
    }
}

__device__ __forceinline__ void norm_mod_phase(const float* src0, const float* src1, int nrows, bf16_t* dst, const float* w,
                                               const float* modsrc, int nparts, const float* bias, int sh_off, int sc_off, LAS unsigned char* lds) {
    int tid_l = threadIdx.x; asm volatile("" : "+v"(tid_l)); const int tid = tid_l, lane = tid & 63, wave = tid >> 6, G = gridDim.x;
    LAS float* CA = (LAS float*)lds;
    LAS float* CB = CA + 3072;
    for (int idx = tid; idx < 3072; idx += NTHREADS) {
        const int r = idx >> 10, k = idx & 1023;
        float sh = bias ? bias[sh_off + k] : 0.f, sc = bias ? bias[sc_off + k] : 0.f;
        for (int p = 0; p < nparts; ++p) { sh += modsrc[(size_t)(p * 3 + r) * 6144 + sh_off + k]; sc += modsrc[(size_t)(p * 3 + r) * 6144 + sc_off + k]; }
        CA[idx] = w[k] * (1.0f + sc); CB[idx] = sh;
    }
    __syncthreads();
    for (int row = blockIdx.x * NWAVES + wave; row < nrows; row += G * NWAVES) {
        const float* xr = row < MX ? src0 + (size_t)row * 1024 : src1 + (size_t)(row - MX) * 1024;
        const int r = row < MX ? (row >= SEQ ? 1 : 0) : 2;
        f32x4 v[4]; float s = 0.f;
#pragma unroll
        for (int j = 0; j < 4; ++j) { v[j] = *(const f32x4*)(xr + 4 * lane + 256 * j); s += (v[j][0] * v[j][0] + v[j][1] * v[j][1]) + (v[j][2] * v[j][2] + v[j][3] * v[j][3]); }
        const float rstd = rsqrtf(wave_sum(s) * (1.0f / 1024.0f) + 1e-6f);
#pragma unroll
        for (int j = 0; j < 4; ++j) {
            const f32x4 a = *(const LAS f32x4*)(CA + r * 1024 + 4 * lane + 256 * j), b = *(const LAS f32x4*)(CB + r * 1024 + 4 * lane + 256 * j);
            const f32x4 y = v[j] * rstd * a + b;
            u32x2 o; o.x = pkbf(y[0], y[1]); o.y = pkbf(y[2], y[3]);
            *(u32x2*)(dst + (size_t)row * 1024 + 4 * lane + 256 * j) = o;
        }
    }
}
__device__ __forceinline__ void final_norm_phase(float* io, const float* w) {
    int tid_l = threadIdx.x; asm volatile("" : "+v"(tid_l)); const int tid = tid_l, lane = tid & 63, wave = tid >> 6, G = gridDim.x;
    for (int row = blockIdx.x * NWAVES + wave; row < MX; row += G * NWAVES) {
        float* xr = io + (size_t)row * 1024;
        f32x4 v[4]; float s = 0.f;
#pragma unroll
        for (int j = 0; j < 4; ++j) { v[j] = *(const f32x4*)(xr + 4 * lane + 256 * j); s += (v[j][0] * v[j][0] + v[j][1] * v[j][1]) + (v[j][2] * v[j][2] + v[j][3] * v[j][3]); }
        const float rstd = rsqrtf(wave_sum(s) * (1.0f / 1024.0f) + 1e-6f);
#pragma unroll
        for (int j = 0; j < 4; ++j) { const f32x4 a = *(const f32x4*)(w + 4 * lane + 256 * j); *(f32x4*)(xr + 4 * lane + 256 * j) = v[j] * rstd * a; }
    }
}
__device__ __forceinline__ void norm_h_phase(const float* oh, const float* nw, bf16_t* ya) {
    int tid_l = threadIdx.x; asm volatile("" : "+v"(tid_l)); const int tid = tid_l, lane = tid & 63, wave = tid >> 6, G = gridDim.x;
    for (int row = blockIdx.x * NWAVES + wave; row < MX; row += G * NWAVES) {
        const float* xr = oh + (size_t)row * 1024 + 16 * lane;
        f32x4 v[4]; float s = 0.f;
#pragma unroll
        for (int j = 0; j < 4; ++j) { v[j] = *(const f32x4*)(xr + 4 * j); s += (v[j][0] * v[j][0] + v[j][1] * v[j][1]) + (v[j][2] * v[j][2] + v[j][3] * v[j][3]); }
        s += __shfl_xor(s, 1); s += __shfl_xor(s, 2); s += __shfl_xor(s, 4);
        const float rstd = rsqrtf(s * (1.0f / 128.0f) + 1e-6f);
        u32x4 o[2];
#pragma unroll
        for (int j = 0; j < 4; ++j) { const f32x4 a = *(const f32x4*)(nw + 16 * lane + 4 * j); const f32x4 y = v[j] * rstd * a;
            o[j >> 1][(j & 1) * 2] = pkbf(y[0], y[1]); o[j >> 1][(j & 1) * 2 + 1] = pkbf(y[2], y[3]); }
        *(u32x4*)(ya + (size_t)row * 1024 + 16 * lane) = o[0]; *(u32x4*)(ya + (size_t)row * 1024 + 16 * lane + 8) = o[1];
    }
}
__device__ __forceinline__ void norm_r_phase(const bf16_t* orr, bf16_t* yb) {
    int tid_l = threadIdx.x; asm volatile("" : "+v"(tid_l)); const int tid = tid_l, lane = tid & 63, wave = tid >> 6, G = gridDim.x;
    for (int row = blockIdx.x * NWAVES + wave; row < MX; row += G * NWAVES) {
        const bf16_t* xr = orr + (size_t)row * 2048 + 32 * lane;
        float v[32]; float s = 0.f;
#pragma unroll
        for (int j = 0; j < 4; ++j) { const u32x4 q = *(const u32x4*)(xr + 8 * j);
#pragma unroll
            for (int e = 0; e < 4; ++e) { v[8 * j + 2 * e] = bflo(q[e]); v[8 * j + 2 * e + 1] = bfhi(q[e]); } }
#pragma unroll
        for (int e = 0; e < 32; ++e) s += v[e];
        s += __shfl_xor(s, 1); s += __shfl_xor(s, 2); s += __shfl_xor(s, 4);
        const float mu = s * (1.0f / 256.0f); float q2 = 0.f;
#pragma unroll
        for (int e = 0; e < 32; ++e) { v[e] -= mu; q2 += v[e] * v[e]; }
        q2 += __shfl_xor(q2, 1); q2 += __shfl_xor(q2, 2); q2 += __shfl_xor(q2, 4);
        const float rstd = rsqrtf(q2 * (1.0f / 256.0f) + 1e-5f);
#pragma unroll
        for (int j = 0; j < 4; ++j) { u32x4 o;
#pragma unroll
            for (int e = 0; e < 4; ++e) o[e] = pkbf(v[8 * j + 2 * e] * rstd, v[8 * j + 2 * e + 1] * rstd);
            *(u32x4*)(yb + (size_t)row * 2048 + 32 * lane + 8 * j) = o; }
    }
}

#define MFMA32(a, b, c) __builtin_amdgcn_mfma_f32_32x32x16_bf16((a), (b), (c), 0, 0, 0)
__device__ __forceinline__ int crow(int reg, int h) { return (reg & 3) + 8 * (reg >> 2) + 4 * h; }
__device__ __forceinline__ bf16x8 pack_step(const f32x16& x, int s) {
    u32x4 p; p.x = pkbf(x[8 * s], x[8 * s + 1]); p.y = pkbf(x[8 * s + 2], x[8 * s + 3]); p.z = pkbf(x[8 * s + 4], x[8 * s + 5]); p.w = pkbf(x[8 * s + 6], x[8 * s + 7]);
    return __builtin_bit_cast(bf16x8, p);
}
constexpr int SB_QT = 0, SB_KT = 8704, SB_KTT = 17408, SB_V = 27648, SB_G = 36352, SB_BYTES = 36864;
constexpr int QS = 136, TS = 40;
constexpr int NSEG_H = 16, NSEG_R = 8;

struct ScanItem {
    const bf16_t* q;
    const unsigned short *kl0, *kl1;
    const bf16_t* v; int ldv;
    float lg0, lg1;
    int row_base, nchunk;
    const float *ctx0, *ctx1;
    const float *us0, *us1;
    const float *gs0, *gs1;
    float segdec0, segdec1;
    int m, nseg;
    float *so0, *so1;
    float *go0, *go1;
    float* of32; bf16_t* obf; int ldo;
    int dry;
};

template <int KIND, int PASS>
__device__ __forceinline__ void scan_item(LAS unsigned char* lds, const ScanItem& a) {
    int tid_l = threadIdx.x; asm volatile("" : "+v"(tid_l)); const int tid = tid_l, dir = __builtin_amdgcn_readfirstlane(tid >> 8), t = tid & 255, w4 = __builtin_amdgcn_readfirstlane(t >> 6), lane = t & 63, r = lane & 31, hh = lane >> 5;
    const int n = a.nchunk, d = 32 * w4 + r;
    const unsigned short* klp = dir ? a.kl1 : a.kl0;
    const float lg = dir ? a.lg1 : a.lg0;
    f32x16 S[4];
    if (PASS == 1) {
        const float* U = (dir ? a.us1 : a.us0) + (size_t)a.m * 16384;
#pragma unroll
        for (int g = 0; g < 4; ++g)
#pragma unroll
            for (int i = 0; i < 16; ++i) S[g][i] = U[(32 * g + crow(i, hh)) * 128 + 32 * w4 + r];
    } else {
#pragma unroll
        for (int g = 0; g < 4; ++g)
#pragma unroll
            for (int i = 0; i < 16; ++i) S[g][i] = 0.f;
    }
    float gtot = 0.f;
    u32x4 rq0, rq1, rk0, rk1, rv0, rv1;
    const int vs = t >> 3, vq = t & 7;
#define LOAD_RAW(jn) do { \
        const int c_ = dir ? n - 1 - (jn) : (jn); \
        const size_t row_ = (size_t)a.row_base + 32 * c_ + (dir ? 31 - vs : vs); \
        if (PASS == 1) { rq0 = *(const u32x4*)(a.q + row_ * 1024 + 16 * vq); rq1 = *(const u32x4*)(a.q + row_ * 1024 + 16 * vq + 8); } \
        rk0 = *(const u32x4*)(klp + row_ * 1024 + 16 * vq); rk1 = *(const u32x4*)(klp + row_ * 1024 + 16 * vq + 8); \
        rv0 = *(const u32x4*)(a.v + row_ * a.ldv + 16 * vq); rv1 = *(const u32x4*)(a.v + row_ * a.ldv + 16 * vq + 8); \
    } while (0)
    LOAD_RAW(0);
    for (int j = 0; j < n; ++j) {
        LAS unsigned char* L = lds + (dir * 2 + (j & 1)) * SB_BYTES;
        LAS bf16_t* QT = (LAS bf16_t*)(L + SB_QT); LAS bf16_t* KT = (LAS bf16_t*)(L + SB_KT);
        LAS bf16_t* KTT = (LAS bf16_t*)(L + SB_KTT); LAS bf16_t* VR = (LAS bf16_t*)(L + SB_V);
        LAS float* GV = (LAS float*)(L + SB_G);
        if (PASS == 1) { *(LAS u32x4*)(QT + vs * QS + 16 * vq) = rq0; *(LAS u32x4*)(QT + vs * QS + 16 * vq + 8) = rq1; }
        *(LAS u32x4*)(KT + vs * QS + 16 * vq) = rk0; *(LAS u32x4*)(KT + vs * QS + 16 * vq + 8) = rk1;
        *(LAS u32x4*)(VR + vs * QS + 16 * vq) = rv0; *(LAS u32x4*)(VR + vs * QS + 16 * vq + 8) = rv1;
        asm volatile("s_waitcnt lgkmcnt(0)" ::: "memory"); __builtin_amdgcn_s_barrier(); asm volatile("" ::: "memory");
        {
            float b[16], kk[16]; unsigned short rk[16];
#pragma unroll
            for (int ii = 0; ii < 16; ++ii) rk[ii] = KT[(16 * hh + ii) * QS + d];
            if (KIND == 0) {
                float run = 0.f;
#pragma unroll
                for (int ii = 0; ii < 16; ++ii) { const float lf = f16tof(rk[ii]); run += lf; b[ii] = run; kk[ii] = 1.0f - __expf(lf); }
                const float other = __shfl_xor(run, 32);
                const float off = hh ? other : 0.f;
#pragma unroll
                for (int ii = 0; ii < 16; ++ii) b[ii] += off;
                if (hh == 0) GV[d] = __expf(run + other);
                gtot += run + other;
            } else {
#pragma unroll
                for (int ii = 0; ii < 16; ++ii) { b[ii] = (float)(16 * hh + ii + 1) * lg; kk[ii] = bf2f(rk[ii]); }
                if (hh == 0) GV[d] = __expf(32.0f * lg);
            }
            unsigned kt[8];
#pragma unroll
            for (int ii = 0; ii < 16; ii += 2) {
                const float e0 = __expf(b[ii]), e1 = __expf(b[ii + 1]);
                const unsigned kq = pkbf(kk[ii] * __builtin_amdgcn_rcpf(e0), kk[ii + 1] * __builtin_amdgcn_rcpf(e1));
                kt[ii >> 1] = kq;
                const int i = 16 * hh + ii;
                if (PASS == 1) {
                    const unsigned qq = pkbf(bf2f(QT[i * QS + d]) * e0, bf2f(QT[(i + 1) * QS + d]) * e1);
                    QT[i * QS + d] = (bf16_t)(qq & 0xffffu); QT[(i + 1) * QS + d] = (bf16_t)(qq >> 16);
                    KT[i * QS + d] = (bf16_t)(kq & 0xffffu); KT[(i + 1) * QS + d] = (bf16_t)(kq >> 16);
                }
            }
            *(LAS u32x4*)(KTT + d * TS + 16 * hh) = (u32x4){kt[0], kt[1], kt[2], kt[3]};
            *(LAS u32x4*)(KTT + d * TS + 16 * hh + 8) = (u32x4){kt[4], kt[5], kt[6], kt[7]};
        }
        if (PASS == 1 && j == (n >> 1)) asm volatile("s_waitcnt vmcnt(0)" ::: "memory");
        asm volatile("s_waitcnt lgkmcnt(0)" ::: "memory"); __builtin_amdgcn_s_barrier(); asm volatile("" ::: "memory");
        if (j + 1 < n) LOAD_RAW(j + 1);
        f32x4 old[4];
        const int c_out = dir ? n - 1 - j : j;
        const size_t row_out = (size_t)a.row_base + 32 * c_out + (dir ? 31 - r : r);
        if (PASS == 1) {
            if (j >= (n >> 1)) {
                if (KIND == 0) { const float* pb = a.of32 + row_out * a.ldo + 32 * w4 + 4 * hh;
#pragma unroll
                    for (int g = 0; g < 4; ++g) old[g] = *(const f32x4*)(pb + 8 * g); }
                else { const bf16_t* pb = a.obf + row_out * a.ldo + 32 * w4 + 4 * hh;
#pragma unroll
                    for (int g = 0; g < 4; ++g) { const u32x2 q2 = *(const u32x2*)(pb + 8 * g); old[g] = (f32x4){bflo(q2.x), bfhi(q2.x), bflo(q2.y), bfhi(q2.y)}; } }
            } else {
#pragma unroll
                for (int g = 0; g < 4; ++g) old[g] = (f32x4){0.f, 0.f, 0.f, 0.f};
            }
        }
#define OUTPUT_STORE() do { \
            if (KIND == 0) { float* pb = a.of32 + row_out * a.ldo + 32 * w4 + 4 * hh; \
                _Pragma("unroll") for (int g = 0; g < 4; ++g) *(f32x4*)(pb + 8 * g) = (f32x4){o[4 * g], o[4 * g + 1], o[4 * g + 2], o[4 * g + 3]} + old[g]; } \
            else { bf16_t* pb = a.obf + row_out * a.ldo + 32 * w4 + 4 * hh; \
                _Pragma("unroll") for (int g = 0; g < 4; ++g) { u32x2 w_; w_.x = pkbf(o[4 * g] + old[g][0], o[4 * g + 1] + old[g][1]); w_.y = pkbf(o[4 * g + 2] + old[g][2], o[4 * g + 3] + old[g][3]); *(u32x2*)(pb + 8 * g) = w_; } } \
        } while (0)
        bf16x8 vb[2];
#pragma unroll
        for (int ks = 0; ks < 2; ++ks) {
            u32x4 p;
#pragma unroll
            for (int jj = 0; jj < 8; jj += 2) {
                const unsigned lo = VR[(16 * ks + 8 * (jj >> 2) + 4 * hh + (jj & 3)) * QS + 32 * w4 + r];
                const unsigned hi = VR[(16 * ks + 8 * (jj >> 2) + 4 * hh + (jj & 3) + 1) * QS + 32 * w4 + r];
                p[jj >> 1] = lo | (hi << 16);
            }
            vb[ks] = __builtin_bit_cast(bf16x8, p);
        }
        if (PASS == 1) {
            f32x16 at;
#pragma unroll
            for (int i = 0; i < 16; ++i) at[i] = 0.f;
#pragma unroll
            for (int ks = 0; ks < 8; ++ks) {
                const bf16x8 ka = *(const LAS bf16x8*)(KT + r * QS + 16 * ks + 8 * hh);
                const bf16x8 qb = *(const LAS bf16x8*)(QT + r * QS + 16 * ks + 8 * hh);
                at = MFMA32(ka, qb, at);
            }
#pragma unroll
            for (int i = 0; i < 16; ++i) if (crow(i, hh) > r) at[i] = 0.f;
            f32x16 o;
#pragma unroll
            for (int i = 0; i < 16; ++i) o[i] = 0.f;
#pragma unroll
            for (int ks = 0; ks < 2; ++ks) o = MFMA32(vb[ks], pack_step(at, ks), o);
#pragma unroll
            for (int g = 0; g < 4; ++g)
#pragma unroll
                for (int ks = 0; ks < 2; ++ks) {
                    const s16x4 qlo = *(const LAS s16x4*)(QT + r * QS + 32 * g + 16 * ks + 4 * hh), qhi = *(const LAS s16x4*)(QT + r * QS + 32 * g + 16 * ks + 8 + 4 * hh);
                    const bf16x8 qa = __builtin_shufflevector(qlo, qhi, 0, 1, 2, 3, 4, 5, 6, 7);
                    o = MFMA32(pack_step(S[g], ks), qa, o);
                }
            OUTPUT_STORE();
        }
#pragma unroll
        for (int g = 0; g < 4; ++g) {
#pragma unroll
            for (int ks = 0; ks < 2; ++ks) {
                const s16x4 klo = *(const LAS s16x4*)(KTT + (32 * g + r) * TS + 16 * ks + 4 * hh), khi = *(const LAS s16x4*)(KTT + (32 * g + r) * TS + 16 * ks + 8 + 4 * hh);
                const bf16x8 ka = __builtin_shufflevector(klo, khi, 0, 1, 2, 3, 4, 5, 6, 7);
                S[g] = MFMA32(ka, vb[ks], S[g]);
            }
#pragma unroll
            for (int q4 = 0; q4 < 4; ++q4) { const f32x4 gv = *(const LAS f32x4*)(GV + 32 * g + 8 * q4 + 4 * hh);
#pragma unroll
                for (int jj = 0; jj < 4; ++jj) S[g][4 * q4 + jj] *= gv[jj]; }
        }
    }
#undef LOAD_RAW
#undef OUTPUT_STORE
    if (PASS == 0) {
        float* so = dir ? a.so1 : a.so0;
#pragma unroll
        for (int g = 0; g < 4; ++g)
#pragma unroll
            for (int i = 0; i < 16; ++i) so[(32 * g + crow(i, hh)) * 128 + 32 * w4 + r] = S[g][i];
        float* go = dir ? a.go1 : a.go0;
        if (KIND == 0 && go && hh == 0) go[d] = gtot;
    }
    __syncthreads();
}

__device__ __forceinline__ float log_sigmoid_(float th) { return -log1pf(expf(-th)); }

template <int KIND>
__device__ __forceinline__ void fold_phase(const Params& P) {
    unsigned char* ws = P.ws;
    constexpr int NSEG = KIND == 0 ? NSEG_H : NSEG_R, NSEQ = KIND == 0 ? 16 : 32, SEGLEN = SEQ / NSEG;
    float* USEG = (float*)(ws + (KIND == 0 ? WS_YA : WS_W_R12));
    const float* CS = (const float*)(ws + (KIND == 0 ? WS_CSH : WS_CSR));
    const float* GS = (const float*)(ws + WS_GSUM);
    const int total = NSEQ * 2 * 4096;
    for (int idx = blockIdx.x * NTHREADS + threadIdx.x; idx < total; idx += gridDim.x * NTHREADS) {
        const int sd = idx >> 12, quad = idx & 4095, d = quad >> 5, c4 = (quad & 31) * 4, dir = sd & 1, sq = sd >> 1;
        f32x4 S = *(const f32x4*)(CS + (size_t)sd * 16384 + d * 128 + c4);
        float* U = USEG + (size_t)sd * NSEG * 16384 + d * 128 + c4;
        float sdec = 0.f;
        if (KIND == 1) { const int h = (sq >> 1) & 7; sdec = __expf(log_sigmoid_(dir ? P.in[13][h] : P.in[12][h]) * (float)SEGLEN); }
        f32x4 u[NSEG]; float dec[NSEG];
#pragma unroll
        for (int q = 0; q < NSEG; ++q) { const int mm = dir ? NSEG - 1 - q : q; u[q] = *(const f32x4*)(U + (size_t)mm * 16384);
            dec[q] = KIND == 0 ? __expf(GS[((size_t)sd * NSEG + mm) * 128 + d]) : sdec; }
#pragma unroll
        for (int q = 0; q < NSEG; ++q) { const int mm = dir ? NSEG - 1 - q : q; *(f32x4*)(U + (size_t)mm * 16384) = S; S = S * dec[q] + u[q]; }
    }
}

template <int KIND, int PASS>
__device__ __forceinline__ void scan_phase(const Params& P, LAS unsigned char* lds) {
    unsigned char* ws = P.ws;
    bf16_t* SCR = (bf16_t*)(ws + WS_SCR);
    constexpr int NSEG = KIND == 0 ? NSEG_H : NSEG_R, NSEQ = KIND == 0 ? 16 : 32, SEGLEN = SEQ / NSEG;
    const int nitems = PASS == 0 ? NSEQ * NSEG + NSEQ : NSEQ * NSEG;
    float* USEG = (float*)(ws + (KIND == 0 ? WS_YA : WS_W_R12));
    float* CS = (float*)(ws + (KIND == 0 ? WS_CSH : WS_CSR));
    float* GS = (float*)(ws + WS_GSUM);
    for (int it = blockIdx.x; it < nitems; it += gridDim.x) {
        const bool isctx = it >= NSEQ * NSEG;
        const int sq = isctx ? it - NSEQ * NSEG : it / NSEG, m = isctx ? 0 : it % NSEG;
        ScanItem a;
        int b, h;
        if (KIND == 0) {
            b = sq >> 3; h = sq & 7;
            a.q = SCR + 128 * h;
            a.kl0 = (const unsigned short*)(SCR + SLOT_ELEMS) + 128 * h; a.kl1 = (const unsigned short*)(SCR + 2 * SLOT_ELEMS) + 128 * h;
            a.v = SCR + 3 * SLOT_ELEMS + 128 * h; a.ldv = 1024; a.lg0 = 0.f; a.lg1 = 0.f; a.segdec0 = 0.f; a.segdec1 = 0.f;
            a.of32 = P.out + 128 * h; a.obf = nullptr; a.ldo = 1024;
        } else {
            const int hv = sq & 1; b = sq >> 4; h = (sq >> 1) & 7;
            a.q = SCR + 128 * h;
            a.kl0 = (const unsigned short*)(SCR + SLOT_ELEMS) + 128 * h; a.kl1 = a.kl0;
            a.v = SCR + 2 * SLOT_ELEMS + 256 * h + 128 * hv; a.ldv = 2048;
            a.lg0 = log_sigmoid_(P.in[12][h]); a.lg1 = log_sigmoid_(P.in[13][h]); a.segdec0 = a.lg0 * (float)SEGLEN; a.segdec1 = a.lg1 * (float)SEGLEN;
            a.of32 = nullptr; a.obf = (bf16_t*)P.out + 256 * h + 128 * hv; a.ldo = 2048;
        }
        a.row_base = isctx ? MX + b * CTXL : b * SEQ + m * SEGLEN; a.nchunk = isctx ? CTXL / 32 : SEGLEN / 32;
        a.ctx0 = CS + (size_t)(sq * 2 + 0) * 16384; a.ctx1 = CS + (size_t)(sq * 2 + 1) * 16384;
        a.us0 = USEG + (size_t)(sq * 2 + 0) * NSEG * 16384; a.us1 = USEG + (size_t)(sq * 2 + 1) * NSEG * 16384;
        a.gs0 = GS + (size_t)(sq * 2 + 0) * NSEG * 128; a.gs1 = GS + (size_t)(sq * 2 + 1) * NSEG * 128;
        a.m = m; a.nseg = NSEG; a.dry = 0;
        if (isctx) { a.so0 = CS + (size_t)(sq * 2 + 0) * 16384; a.so1 = CS + (size_t)(sq * 2 + 1) * 16384; a.go0 = nullptr; a.go1 = nullptr; }
        else { a.so0 = USEG + ((size_t)(sq * 2 + 0) * NSEG + m) * 16384; a.so1 = USEG + ((size_t)(sq * 2 + 1) * NSEG + m) * 16384;
               a.go0 = GS + ((size_t)(sq * 2 + 0) * NSEG + m) * 128; a.go1 = GS + ((size_t)(sq * 2 + 1) * NSEG + m) * 128; }
        scan_item<KIND, PASS>(lds, a);
    }
}

#define XB_TMO      128
#define XB_XCNT(j)  (256  + 64 * (j))
#define XB_XSUB(j)  (1280 + 64 * (j))
#define XB_XGEN(j)  (2304 + 64 * (j))
#define XB_TOP      3328
#define XB_TOPGEN   3392
#define XCD_BAR_WORDS 3456
#define XB_SPIN_CAP (1u << 18)

__device__ __forceinline__ unsigned xb_ld(unsigned* p)              { return __hip_atomic_load(p, __ATOMIC_RELAXED, __HIP_MEMORY_SCOPE_AGENT); }
__device__ __forceinline__ unsigned xb_add(unsigned* p, unsigned v) { return __hip_atomic_fetch_add(p, v, __ATOMIC_RELAXED, __HIP_MEMORY_SCOPE_AGENT); }
__device__ __forceinline__ unsigned xb_xcc_id() { return (unsigned)__builtin_amdgcn_s_getreg((3 << 11) | 20) & 0xFu; }
#define XB_SPIN(cond, bar) do { unsigned _sp = 0; while (cond) { __builtin_amdgcn_s_sleep(1); \
    if ((++_sp & 255u) == 0u) { if (xb_ld(&(bar)[XB_TMO])) break; if (_sp > XB_SPIN_CAP) { atomicAdd(&(bar)[XB_TMO], 1u); break; } } } } while (0)

struct XcdBarrier {
    unsigned* bar; unsigned x;
    volatile LAS unsigned* st;
};

__device__ __forceinline__ XcdBarrier xcd_barrier_post(unsigned* bar, volatile LAS unsigned* st) {
    XcdBarrier b; b.bar = bar; b.x = xb_xcc_id(); b.st = st;
    if (threadIdx.x == 0) (void)xb_add(&bar[XB_XCNT(b.x)], 1u);
    return b;
}
__device__ __forceinline__ void xcd_barrier_complete(unsigned* bar, unsigned x, unsigned& nloc, unsigned& nx) {
    const unsigned G = gridDim.x * gridDim.y * gridDim.z;
    unsigned sum, cnt, mine, sp = 0u;
    for (;;) {
        sum = 0u; cnt = 0u; mine = 0u;
#pragma unroll
        for (unsigned j = 0; j < 16; ++j) { const unsigned c = xb_ld(&bar[XB_XCNT(j)]); sum += c; cnt += (c > 0u) ? 1u : 0u; mine = (j == x) ? c : mine; }
        if (sum == G) break;
        __builtin_amdgcn_s_sleep(1);
        if ((++sp & 255u) == 0u) { if (xb_ld(&bar[XB_TMO])) break; if (sp > XB_SPIN_CAP) { atomicAdd(&bar[XB_TMO], 1u); break; } }
    }
    nloc = mine > 0u ? mine : 1u; nx = cnt > 0u ? cnt : 1u;
}

__device__ __forceinline__ void xcd_barrier(const XcdBarrier& b) {
    asm volatile("s_waitcnt vmcnt(0)" ::: "memory");
    __syncthreads();
    if (threadIdx.x == 0) {
        unsigned* bar = b.bar;
        __builtin_amdgcn_s_waitcnt(0);
        unsigned nloc = b.st[0], nx = b.st[1];
        if (nloc == 0u) { xcd_barrier_complete(bar, b.x, nloc, nx); b.st[0] = nloc; b.st[1] = nx; }
        const unsigned old = xb_add(&bar[XB_XSUB(b.x)], 1u);
        const unsigned gen = old / nloc;
        if (old + 1u == (gen + 1u) * nloc) {
            __builtin_amdgcn_fence(__ATOMIC_RELEASE, "agent");
            asm volatile("s_waitcnt vmcnt(0)" ::: "memory");
            const unsigned og = xb_add(&bar[XB_TOP], 1u);
            const unsigned tg = og / nx;
            if (og + 1u == (tg + 1u) * nx) xb_add(&bar[XB_TOPGEN], 1u);
            else XB_SPIN(xb_ld(&bar[XB_TOPGEN]) == tg, bar);
            __builtin_amdgcn_fence(__ATOMIC_ACQUIRE, "agent");
            xb_add(&bar[XB_XGEN(b.x)], 1u);
            asm volatile("s_waitcnt vmcnt(0)" ::: "memory");
        } else {
            XB_SPIN(xb_ld(&bar[XB_XGEN(b.x)]) == gen, bar);
            __builtin_amdgcn_fence(__ATOMIC_ACQUIRE, "agent");
            asm volatile("s_waitcnt vmcnt(0)" ::: "memory");
        }
    }
    __syncthreads();
}

template <int MODE>
__device__ __forceinline__ void run_gemm(LAS unsigned char* lds, const bf16_t* A, const bf16_t* Bt, int M, int N, int K, const Params& P) {
    pg8::Gemm g{A, Bt, M, N, K}; pg8::StaticOrder S; S.init(M, N, (int)gridDim.x, (int)blockIdx.x);
    EpiAll<MODE> E; E.ws = P.ws; E.x = P.in[0]; E.out = P.out;
    pg8::gemm_phase<EpiAll<MODE>, pg8::StaticOrder, true, true>(lds, g, S, E);
}

#ifndef REP_HA
#define REP_HA 1
#endif
#ifndef REP_HB
#define REP_HB 1
#endif
#ifndef REP_RA
#define REP_RA 1
#endif
#ifndef REP_RB
#define REP_RB 1
#endif
#ifndef REP_R1
#define REP_R1 1
#endif
#ifndef REP_SMALL
#define REP_SMALL 1
#endif
#ifndef DRY_HB
#define DRY_HB 0
#endif
#ifndef REP_GU
#define REP_GU 1
#endif
#ifdef PROBE_TS
#define TSTAMP(k) do { if (blockIdx.x == 0 && threadIdx.x == 0) ((volatile unsigned long long*)(ws + WS_END))[k] = __builtin_amdgcn_s_memrealtime(); } while (0)
#else
#define TSTAMP(k) do {} while (0)
#endif
#ifdef USE_CG_SYNC
#define GRID_BAR() grid.sync()
#else
#define GRID_BAR() do { XcdBarrier b_; b_.bar = (unsigned*)(P.ws + WS_BAR); b_.x = xb_xcc_id(); b_.st = (volatile LAS unsigned*)(lds + 4 * 36864); xcd_barrier(b_); } while (0)
#endif
__global__ void __launch_bounds__(NTHREADS, 2) mk_fwd(Params P) {
    extern __shared__ __attribute__((aligned(16))) unsigned char lds_raw[];
    LAS unsigned char* lds = (LAS unsigned char*)lds_raw;
    cg::grid_group grid = cg::this_grid();
    unsigned char* ws = P.ws;
    volatile LAS unsigned* MISC = (volatile LAS unsigned*)(lds + 4 * 36864);
    if (threadIdx.x < 2) MISC[threadIdx.x] = 0u;
    __syncthreads();
    (void)xcd_barrier_post((unsigned*)(ws + WS_BAR), MISC);
    bf16_t* W_R12 = (bf16_t*)(ws + WS_W_R12); bf16_t* HX = (bf16_t*)(ws + WS_HX); bf16_t* YA = (bf16_t*)(ws + WS_YA); bf16_t* SCR = (bf16_t*)(ws + WS_SCR);

    TSTAMP(0);
    for (int rep_ = 0; rep_ < REP_SMALL; ++rep_) { p0_phase(P, lds); GRID_BAR(); }
    if (P.ws == nullptr) grid.sync();
    TSTAMP(1);
    for (int rep_ = 0; rep_ < REP_SMALL; ++rep_) { norm_mod_phase(P.in[0], P.in[2], MT, HX, P.in[6], (const float*)(ws + WS_MODP), 8, P.in[5], 0, 1024, lds); __syncthreads(); }
    {
        float* modf_ = (float*)(ws + WS_MODF); const float* modp = (const float*)(ws + WS_MODP);
        const int idx = blockIdx.x * NTHREADS + threadIdx.x;
        for (int i = idx; i < 3 * 6144; i += gridDim.x * NTHREADS) { const int r = i / 6144, jx = i % 6144; float s = P.in[5][jx];
            for (int p = 0; p < 8; ++p) s += modp[(size_t)(p * 3 + r) * 6144 + jx];
            modf_[i] = s; }
    }
    GRID_BAR(); TSTAMP(2);
    for (int rep_ = 0; rep_ < REP_R1; ++rep_) { run_gemm<1>(lds, HX, W_R12, MT, 4096, 1024, P); GRID_BAR(); } TSTAMP(3);
    for (int rep_ = 0; rep_ < REP_HA; ++rep_) { scan_phase<0, 0>(P, lds); GRID_BAR(); } TSTAMP(4);
    fold_phase<0>(P); GRID_BAR();
    for (int rep_ = 0; rep_ < REP_HB; ++rep_) { scan_phase<0, 1>(P, lds); GRID_BAR(); } TSTAMP(5);
    for (int rep_ = 0; rep_ < REP_SMALL; ++rep_) norm_h_phase(P.out, P.in[11], YA);
    TSTAMP(6);
    run_gemm<2>(lds, HX, W_R12 + (size_t)4096 * 1024, MT, 4096, 1024, P);
    GRID_BAR(); TSTAMP(7);
    for (int rep_ = 0; rep_ < REP_RA; ++rep_) { scan_phase<1, 0>(P, lds); GRID_BAR(); } TSTAMP(8);
    fold_phase<1>(P); GRID_BAR();
    for (int rep_ = 0; rep_ < REP_RB; ++rep_) { scan_phase<1, 1>(P, lds); GRID_BAR(); } TSTAMP(9);
    for (int rep_ = 0; rep_ < REP_SMALL; ++rep_) { norm_r_phase((const bf16_t*)P.out, SCR); p0b_phase(P, lds); }
    GRID_BAR(); TSTAMP(10);
    run_gemm<3>(lds, HX, (const bf16_t*)(ws + WS_W_R3), MX, 5120, 1024, P);
    GRID_BAR(); TSTAMP(11);
    run_gemm<4>(lds, YA, (const bf16_t*)(ws + WS_W_PA), MX, 1024, 1024, P);
    run_gemm<5>(lds, SCR, (const bf16_t*)(ws + WS_W_PB), MX, 1024, 2048, P);
    GRID_BAR(); TSTAMP(12);
    run_gemm<6>(lds, HX, (const bf16_t*)(ws + WS_W_OUT), MX, 1024, 1024, P);
    GRID_BAR(); TSTAMP(13);
    for (int rep_ = 0; rep_ < REP_SMALL; ++rep_) { norm_mod_phase(P.out, nullptr, MX, YA, P.in[7], (const float*)(ws + WS_MODF), 1, nullptr, 3072, 4096, lds); __syncthreads(); }
    GRID_BAR(); TSTAMP(14);
    for (int rep_ = 0; rep_ < REP_GU; ++rep_) { run_gemm<7>(lds, YA, (const bf16_t*)(ws + WS_W_GU), MX, 5632, 1024, P); GRID_BAR(); } TSTAMP(15);
    run_gemm<8>(lds, SCR, (const bf16_t*)(ws + WS_W_DN), MX, 1024, DFF, P);
    GRID_BAR(); TSTAMP(16);
#ifdef REP_SYNC
    for (int rep_ = 0; rep_ < REP_SYNC; ++rep_) GRID_BAR();
#endif
    final_norm_phase(P.out, P.in[20]);
#ifdef PROBE_TS
    GRID_BAR(); TSTAMP(17);
    if (blockIdx.x == 0 && threadIdx.x == 0) { volatile unsigned long long* ts = (volatile unsigned long long*)(ws + WS_END);
        const float T1 = (float)(ts[PROBE_A1] - ts[PROBE_A0]) * 0.01f, T2 = (float)(ts[PROBE_B1] - ts[PROBE_B0]) * 0.01f;
        P.out[0] = T1; for (int i = 0; i < 10000; ++i) P.out[1024 + i] = T2; }
#endif
}

extern "C" void kernel_launch(void* const* d_in, const int* in_sizes, int n_in, void* d_out, int out_size, void* d_ws, size_t ws_size, hipStream_t stream) {
    static int grid_blocks = 0;
    if (grid_blocks == 0) {
        if (n_in != 21 || ws_size < WS_BAR + XCD_BAR_WORDS * 4) { fprintf(stderr, "kernel_launch: unexpected n_in %d / ws_size %zu (need %zu)\n", n_in, ws_size, (size_t)WS_END); grid_blocks = -1; return; }
        int dev = 0, cus = 0, per_cu = 0;
        hipGetDevice(&dev);
        hipDeviceGetAttribute(&cus, hipDeviceAttributeMultiprocessorCount, dev);
        hipFuncSetAttribute((const void*)mk_fwd, hipFuncAttributeMaxDynamicSharedMemorySize, LDS_BYTES);
        hipOccupancyMaxActiveBlocksPerMultiprocessor(&per_cu, (const void*)mk_fwd, NTHREADS, LDS_BYTES);
        if (per_cu < 1) per_cu = 1;
        grid_blocks = cus * per_cu;
        (void)hipGetLastError();
    }
    if (grid_blocks < 0) return;
    (void)hipMemsetAsync((unsigned char*)d_ws + WS_BAR, 0, XCD_BAR_WORDS * 4, stream);
    Params p{};
    for (int i = 0; i < 21; ++i) p.in[i] = (const float*)d_in[i];
    p.out = (float*)d_out; p.ws = (unsigned char*)d_ws;
    void* args[] = {&p};
    hipError_t e = hipLaunchCooperativeKernel((const void*)mk_fwd, dim3(grid_blocks), dim3(NTHREADS), args, LDS_BYTES, stream);
    if (e != hipSuccess) fprintf(stderr, "cooperative launch failed: %s (grid %d)\n", hipGetErrorString(e), grid_blocks);
}
```
